# Optimizing an MI355X kernel written in HIP

```python
import jax, jax.numpy as jnp
from jax import lax
import numpy as np

D_MODEL = 1024
BATCH = 8
SEQ = 4096
DEPTH = 4

N_MIXERS = 2
SB_HEADS = 16
SB_HEAD_DIM = D_MODEL // SB_HEADS
Q_BLOCK = 128
RET_HEADS = 8
RET_QK_DIM = D_MODEL // RET_HEADS
RET_V_DIM = 2 * RET_QK_DIM
RET_CHUNK = 128
ROPE_BASE = 10000.0
N_EXPERTS = 16
N_GROUPS = 4
EXPERTS_PER_GROUP = N_EXPERTS // N_GROUPS
TOP_K = 2
D_EXPERT = D_MODEL // 2
N_SB = (DEPTH + 1) // 2
N_RET = DEPTH // 2
DEEPNORM_ALPHA = (2 * DEPTH) ** 0.25
DEEPNORM_BETA = (8 * DEPTH) ** -0.25
LN_EPS = 1e-5

kernel_name = "hybrid_stickbreak_retention_groupmoe"


def layer_norm(x, g, b):
    xf = x.astype(jnp.float32)
    mu = jnp.mean(xf, axis=-1, keepdims=True)
    var = jnp.mean(jnp.square(xf - mu), axis=-1, keepdims=True)
    y = (xf - mu) * lax.rsqrt(var + LN_EPS) * g.astype(jnp.float32) + b.astype(jnp.float32)
    return y.astype(x.dtype)


def adaln_params(c, w, b):
    m = jax.nn.silu(c) @ w + b
    shift, scale, gate = jnp.split(m, 3, axis=-1)
    return shift[:, None, :], scale[:, None, :], gate[:, None, :]


def stick_breaking_attention(h, w_in, w_out):
    B, S, _ = h.shape
    qkv = (h @ w_in).reshape(B, S, 3, SB_HEADS, SB_HEAD_DIM)
    q = qkv[:, :, 0].transpose(0, 2, 1, 3)
    k = qkv[:, :, 1].transpose(0, 2, 1, 3)
    v = qkv[:, :, 2].transpose(0, 2, 1, 3)
    n_blocks = S // Q_BLOCK
    q_blocks = q.reshape(B, SB_HEADS, n_blocks, Q_BLOCK, SB_HEAD_DIM).transpose(2, 0, 1, 3, 4)
    key_pos = jnp.arange(S)
    scale = SB_HEAD_DIM ** -0.5

    def block(args):
        qb, i = args
        z = jnp.einsum('bhqd,bhkd->bhqk', qb, k).astype(jnp.float32) * scale
        q_pos = i * Q_BLOCK + jnp.arange(Q_BLOCK)
        causal = key_pos[None, :] < q_pos[:, None]
        log_keep = jnp.where(causal, jax.nn.log_sigmoid(-z), 0.0)
        suffix = lax.cumsum(log_keep, axis=3, reverse=True) - log_keep
        a = jnp.where(causal, jnp.exp(jax.nn.log_sigmoid(z) + suffix), 0.0)
        return jnp.einsum('bhqk,bhkd->bhqd', a.astype(v.dtype), v)

    o = lax.map(block, (q_blocks, jnp.arange(n_blocks)))
    o = o.transpose(1, 0, 3, 2, 4).reshape(B, S, D_MODEL)
    return o @ w_out


def rotary(x, cos, sin):
    half = x.shape[-1] // 2
    x1, x2 = x[..., :half], x[..., half:]
    return jnp.concatenate([x1 * cos - x2 * sin, x2 * cos + x1 * sin], axis=-1)


def retention(h, positions, w_in, gn_g, w_out):
    B, S, _ = h.shape
    f32 = jnp.float32
    proj = h @ w_in
    q, k, v, g = jnp.split(proj, [D_MODEL, 2 * D_MODEL, 4 * D_MODEL], axis=-1)
    q = q.reshape(B, S, RET_HEADS, RET_QK_DIM).astype(f32)
    k = k.reshape(B, S, RET_HEADS, RET_QK_DIM).astype(f32) * (RET_QK_DIM ** -0.5)
    v = v.reshape(B, S, RET_HEADS, RET_V_DIM).astype(f32)
    inv_freq = 1.0 / (ROPE_BASE ** (jnp.arange(0, RET_QK_DIM, 2, dtype=f32) / RET_QK_DIM))
    ang = positions.astype(f32)[..., None] * inv_freq
    cos = jnp.cos(ang)[:, :, None, :]
    sin = jnp.sin(ang)[:, :, None, :]
    q = rotary(q, cos, sin)
    k = rotary(k, cos, sin)

    log_gamma = jnp.log(1.0 - jnp.exp2(-5.0 - jnp.arange(RET_HEADS, dtype=f32)))
    n = jnp.arange(RET_CHUNK, dtype=f32)
    diff = n[:, None] - n[None, :]
    dmask = jnp.where(diff >= 0, jnp.exp(jnp.maximum(diff, 0.0) * log_gamma[:, None, None]), 0.0)
    xi = jnp.exp((n + 1.0) * log_gamma[:, None])
    zeta = jnp.exp((RET_CHUNK - 1.0 - n) * log_gamma[:, None])
    chunk_decay = jnp.exp(RET_CHUNK * log_gamma)
    n_chunks = S // RET_CHUNK

    def chunks(t):
        return t.reshape(B, n_chunks, RET_CHUNK, RET_HEADS, t.shape[-1]).transpose(1, 0, 3, 2, 4)

    def step(state, xs):
        qc, kc, vc = xs
        qk = jnp.einsum('bhnd,bhmd->bhnm', qc, kc) * dmask
        inner = jnp.einsum('bhnm,bhme->bhne', qk, vc)
        cross = jnp.einsum('bhnd,bhde->bhne', qc, state) * xi[None, :, :, None]
        state = state * chunk_decay[None, :, None, None] + jnp.einsum(
            'bhmd,bhme->bhde', kc * zeta[None, :, :, None], vc)
        return state, inner + cross

    state0 = jnp.zeros((B, RET_HEADS, RET_QK_DIM, RET_V_DIM), f32)
    _, o = lax.scan(step, state0, (chunks(q), chunks(k), chunks(v)))
    o = o.transpose(1, 0, 3, 2, 4).reshape(B, S, RET_HEADS, RET_V_DIM)
    mu = jnp.mean(o, axis=-1, keepdims=True)
    var = jnp.mean(jnp.square(o - mu), axis=-1, keepdims=True)
    o = ((o - mu) * lax.rsqrt(var + LN_EPS)).reshape(B, S, 2 * D_MODEL) * gn_g.astype(f32)
    return (jax.nn.silu(g) * o.astype(h.dtype)) @ w_out


def grouped_moe(h, router_w, router_b, w_gate, w_up, w_down):
    B, S, Dm = h.shape
    t = h.reshape(B * S, Dm)
    logits = t.astype(jnp.float32) @ router_w.astype(jnp.float32) + router_b.astype(jnp.float32)
    probs = jax.nn.softmax(logits, axis=-1)
    grouped = probs.reshape(-1, N_GROUPS, EXPERTS_PER_GROUP)
    group_score = jnp.sum(lax.top_k(grouped, TOP_K)[0], axis=-1)
    sel_group = jnp.argmax(group_score, axis=-1)
    expert_group = jnp.arange(N_EXPERTS) // EXPERTS_PER_GROUP
    in_group = expert_group[None, :] == sel_group[:, None]
    masked = jnp.where(in_group, logits, -jnp.inf)
    top_val, top_idx = lax.top_k(masked, TOP_K)
    top_w = jax.nn.softmax(top_val, axis=-1)
    combine = jnp.sum(jax.nn.one_hot(top_idx, N_EXPERTS, dtype=jnp.float32) * top_w[..., None], axis=1)
    out = jnp.zeros(t.shape, jnp.float32)
    for e in range(N_EXPERTS):
        hidden = jax.nn.silu(t @ w_gate[e]) * (t @ w_up[e])
        out = out + combine[:, e:e + 1] * (hidden @ w_down[e]).astype(jnp.float32)
    return out.astype(h.dtype).reshape(B, S, Dm)


def setup_inputs(seed: int = 0) -> dict:
    key = jax.random.key(seed)
    ks = jax.random.split(key, 20)
    D, F = D_MODEL, D_EXPERT
    nrm = jax.random.normal
    x = nrm(ks[0], (BATCH, SEQ, D), jnp.float32)
    c = nrm(ks[1], (BATCH, D), jnp.float32)
    positions = jnp.broadcast_to(jnp.arange(SEQ, dtype=jnp.int32)[None, :], (BATCH, SEQ))
    ada_w = nrm(ks[2], (DEPTH, 2, D, 3 * D), jnp.float32) * (0.5 * D ** -0.5)
    ada_b = nrm(ks[3], (DEPTH, 2, 3 * D), jnp.float32) * 0.02
    ln_g = 1.0 + 0.02 * nrm(ks[4], (DEPTH, 2, D), jnp.float32)
    ln_b = 0.02 * nrm(ks[5], (DEPTH, 2, D), jnp.float32)
    sb_col = jnp.concatenate([jnp.ones((2 * D,), jnp.float32), jnp.full((D,), DEEPNORM_BETA, jnp.float32)])
    sb_w_in = nrm(ks[6], (N_SB, D, 3 * D), jnp.float32) * (D ** -0.5) * sb_col
    sb_w_out = nrm(ks[7], (N_SB, D, D), jnp.float32) * (D ** -0.5) * DEEPNORM_BETA
    ret_col = jnp.concatenate([jnp.ones((2 * D,), jnp.float32), jnp.full((2 * D,), DEEPNORM_BETA, jnp.float32),
                               jnp.ones((2 * D,), jnp.float32)])
    ret_w_in = nrm(ks[8], (N_RET, D, 6 * D), jnp.float32) * (D ** -0.5) * ret_col
    ret_gn_g = 1.0 + 0.02 * nrm(ks[9], (N_RET, 2 * D), jnp.float32)
    ret_w_out = nrm(ks[10], (N_RET, 2 * D, D), jnp.float32) * ((2 * D) ** -0.5) * DEEPNORM_BETA
    router_w = nrm(ks[11], (D, N_EXPERTS), jnp.float32) * (D ** -0.5)
    router_b = nrm(ks[12], (N_EXPERTS,), jnp.float32) * 0.01
    moe_w_gate = nrm(ks[13], (DEPTH, N_EXPERTS, D, F), jnp.float32) * (D ** -0.5)
    moe_w_up = nrm(ks[14], (DEPTH, N_EXPERTS, D, F), jnp.float32) * (D ** -0.5) * DEEPNORM_BETA
    moe_w_down = nrm(ks[15], (DEPTH, N_EXPERTS, F, D), jnp.float32) * (F ** -0.5) * DEEPNORM_BETA
    return {"x": x, "c": c, "positions": positions, "ada_w": ada_w, "ada_b": ada_b,
            "ln_g": ln_g, "ln_b": ln_b, "sb_w_in": sb_w_in, "sb_w_out": sb_w_out,
            "ret_w_in": ret_w_in, "ret_gn_g": ret_gn_g, "ret_w_out": ret_w_out,
            "router_w": router_w, "router_b": router_b, "moe_w_gate": moe_w_gate,
            "moe_w_up": moe_w_up, "moe_w_down": moe_w_down}


def reference(x, c, positions, ada_w, ada_b, ln_g, ln_b, sb_w_in, sb_w_out, ret_w_in, ret_gn_g,
              ret_w_out, router_w, router_b, moe_w_gate, moe_w_up, moe_w_down):
    for i in range(DEPTH):
        shift, scale, gate = adaln_params(c, ada_w[i, 0], ada_b[i, 0])
        h = x * (1.0 + scale) + shift
        if i % N_MIXERS == 0:
            y = stick_breaking_attention(h, sb_w_in[i // 2], sb_w_out[i // 2])
        else:
            y = retention(h, positions, ret_w_in[i // 2], ret_gn_g[i // 2], ret_w_out[i // 2])
        x = layer_norm(DEEPNORM_ALPHA * x + (1.0 + gate) * y, ln_g[i, 0], ln_b[i, 0])
        shift, scale, gate = adaln_params(c, ada_w[i, 1], ada_b[i, 1])
        h = x * (1.0 + scale) + shift
        y = grouped_moe(h, router_w, router_b, moe_w_gate[i], moe_w_up[i], moe_w_down[i])
        x = layer_norm(DEEPNORM_ALPHA * x + (1.0 + gate) * y, ln_g[i, 1], ln_b[i, 1])
    return x
```

```cpp
#include <hip/hip_runtime.h>
#include <cstdio>
#include <cstdint>
#include <cmath>

#define LAS __attribute__((address_space(3)))
#define GAS __attribute__((address_space(1)))
typedef unsigned short bf16_t;
typedef short bf16x8 __attribute__((ext_vector_type(8)));
typedef short s16x4 __attribute__((ext_vector_type(4)));
typedef float f32x4 __attribute__((ext_vector_type(4)));
typedef float f32x2 __attribute__((ext_vector_type(2)));
typedef float f32x16 __attribute__((ext_vector_type(16)));
typedef unsigned u32x4 __attribute__((ext_vector_type(4)));
typedef unsigned u32x2 __attribute__((ext_vector_type(2)));
typedef __bf16 bf16x2_t __attribute__((ext_vector_type(2)));

constexpr int BATCH = 8, SEQ = 4096, D = 1024, T = BATCH * SEQ, DEPTH = 4;
constexpr int NBUCKET = 24;
constexpr float LN_EPS = 1e-5f;
constexpr float DN_ALPHA = 1.6817928305074292f;
constexpr float LOG2E = 1.4426950408889634f;
constexpr float SB_QSCALE = 0.125f * LOG2E;
constexpr float SB_EXIT = -152.0f;

__device__ __forceinline__ unsigned cvtpk(float lo, float hi) { f32x2 v = {lo, hi}; bf16x2_t b = __builtin_convertvector(v, bf16x2_t); return __builtin_bit_cast(unsigned, b); }
__device__ __forceinline__ float bf2f(unsigned short h) { return __builtin_bit_cast(float, (unsigned)h << 16); }
__device__ __forceinline__ float bflo(unsigned w) { return __builtin_bit_cast(float, w << 16); }
__device__ __forceinline__ float bfhi(unsigned w) { return __builtin_bit_cast(float, w & 0xffff0000u); }
#define LDS_WAIT() asm volatile("s_waitcnt lgkmcnt(0)" ::: "memory")
#define VM_WAIT() asm volatile("s_waitcnt vmcnt(0)" ::: "memory")
#define SBAR() __builtin_amdgcn_sched_barrier(0)

namespace gp {
constexpr int BM = 256, BK = 64, HALF = 128, HTB = HALF * BK * 2, STAGE_BYTES = 8 * HTB, NXCD = 8, WGM = 8;
__host__ __device__ __forceinline__ int lds_byte(int r, int c) { const int st = (r >> 4) * 2 + (c >> 5), rr = r & 15, cc = c & 31, ob = rr * 64 + cc * 2; return st * 1024 + (ob ^ (((ob >> 9) & 1) << 5)); }
__host__ __device__ __forceinline__ void stage_rc(int b, int& R, int& C) { const int st = b / 1024, sb = b % 1024, swz = sb ^ (((sb >> 9) & 1) << 5); R = (st >> 1) * 16 + swz / 64; C = (st & 1) * 32 + (swz % 64) / 2; }
__host__ __device__ __forceinline__ int perm32(int rho) { const int n = rho >> 4, i = rho & 15; return 8 * (i >> 2) + 4 * n + (i & 3); }

__device__ __forceinline__ void lane_rc(int tid, int i, int& R, int& C) { stage_rc(tid * 16 + i * 8192, R, C); }
struct UnitG { int pm, pn; const char* a0; const char* b0; unsigned bjump; int bsplit; int x0, x1; };
struct LaneVA { unsigned v[2][2]; };

struct StaticOrder {
    int nM, nN, nwg, G, c;
    __device__ void init(int M, int N, int G_, int c_) { nM = M / BM; nN = N / BM; nwg = nM * nN; G = G_; c = c_; }
    __device__ bool next(int i, int& pm, int& pn) const {
        const long L = (long)i * G + c; if (L >= nwg) return false;
        int wgid = (int)L; { const int q = nwg / NXCD, r = nwg % NXCD, xcd = wgid % NXCD, off = wgid / NXCD; wgid = (xcd < r ? xcd * (q + 1) : r * (q + 1) + (xcd - r) * q) + off; }
        const int nig = WGM * nN, gid = wgid / nig, fm = gid * WGM, gsz = (nM - fm) < WGM ? (nM - fm) : WGM;
        pm = fm + ((wgid % nig) % gsz); pn = (wgid % nig) / gsz; return true;
    }
};
struct PlainSched {
    static constexpr bool GATHER = false;
    const bf16_t* A; const bf16_t* Bt; int lda, ldb, tid; StaticOrder so;
    __device__ __forceinline__ bool next(int i, UnitG& u, LaneVA&) const {
        int pm, pn; if (!so.next(i, pm, pn)) return false;
        u.pm = pm; u.pn = pn; u.a0 = (const char*)A + (size_t)pm * BM * lda * 2; u.b0 = (const char*)Bt + (size_t)pn * BM * ldb * 2; u.bjump = 0u; u.bsplit = 1 << 30; u.x0 = 0; u.x1 = 0;
        return true;
    }
};

template <class Epi, class Sched>
__device__ __forceinline__ void gemm_phase(LAS unsigned char* lds, const int tid, const int K, const int lda, const int ldb, const Sched& S, const Epi& E) {
    const int wid = __builtin_amdgcn_readfirstlane(tid >> 6), lane = tid & 63, wr = wid >> 2, wc = wid & 3, fr = lane & 15, fq = lane >> 4;
    const int nt = K / BK;
    constexpr bool GA = Sched::GATHER;
    unsigned voffA, voffB;
    { int R, C; stage_rc(tid * 16, R, C); const int Rb = (R & ~31) + perm32(R & 31); voffA = (unsigned)(R * lda + C) * 2u; voffB = (unsigned)(Rb * ldb + C) * 2u; }
    const size_t kstep = (size_t)(BK * 2);
    const size_t hstepB = (size_t)HALF * ldb * 2, pstepB = (size_t)64 * ldb * 2;
    const size_t hstepA = (size_t)HALF * lda * 2, pstepA = (size_t)64 * lda * 2;
    const unsigned ldsw = (unsigned)wid * 1024u;
    const int aoff = lds_byte(wr * 64 + fr, fq * 8), boff = lds_byte(wc * 32 + fr, fq * 8);
#define PG8_SA(b, h) (((b) * 2 + (h)) * HTB)
#define PG8_SB(b, h) ((4 + (b) * 2 + (h)) * HTB)
#define PG8_LD1(bufoff, gptr) __builtin_amdgcn_global_load_lds((const unsigned*)(gptr), (LAS unsigned*)(lds + (bufoff) + ldsw), 16, 0, 0)
#define PG8_STAGE_B(bufoff, gbase) do { PG8_LD1(bufoff, (const char*)(gbase) + voffB); PG8_LD1((bufoff) + 8192, (const char*)(gbase) + pstepB + voffB); } while (0)
#define PG8_STAGE_A(bufoff, gbase, h, VA) do { if constexpr (GA) { PG8_LD1(bufoff, (const char*)(gbase) + (VA).v[h][0]); PG8_LD1((bufoff) + 8192, (const char*)(gbase) + (VA).v[h][1]); } \
        else { PG8_LD1(bufoff, (const char*)(gbase) + (h) * hstepA + voffA); PG8_LD1((bufoff) + 8192, (const char*)(gbase) + (h) * hstepA + pstepA + voffA); } } while (0)
#define PG8_LDA(dst, b, h) do { _Pragma("unroll") for (int m = 0; m < 4; ++m) _Pragma("unroll") for (int k = 0; k < 2; ++k) dst[m][k] = *(const LAS bf16x8*)(lds + PG8_SA(b, h) + aoff + m * 2048 + k * 1024); } while (0)
#define PG8_LDB(dst, b, h) do { _Pragma("unroll") for (int n = 0; n < 2; ++n) _Pragma("unroll") for (int k = 0; k < 2; ++k) dst[n][k] = *(const LAS bf16x8*)(lds + PG8_SB(b, h) + boff + n * 2048 + k * 1024); } while (0)
#define PG8_MMA(ai, bj, At, Bt) do { __builtin_amdgcn_s_setprio(1); _Pragma("unroll") for (int m = 0; m < 4; ++m) _Pragma("unroll") for (int n = 0; n < 2; ++n) _Pragma("unroll") for (int k = 0; k < 2; ++k) \
        acc[ai][bj][m][n] = __builtin_amdgcn_mfma_f32_16x16x32_bf16(Bt[n][k], At[m][k], acc[ai][bj][m][n], 0, 0, 0); __builtin_amdgcn_s_setprio(0); } while (0)
#define PG8_WAIT_V(n) asm volatile("s_waitcnt vmcnt(" #n ")" ::: "memory")
#define PG8_WAIT_L(n) asm volatile("s_waitcnt lgkmcnt(" #n ")" ::: "memory")
#define PG8_BAR __builtin_amdgcn_s_barrier()
#define PG8_BPTR(u, kt) ((u).b0 + (size_t)(kt) * kstep + (((kt) >= (u).bsplit) ? (size_t)(u).bjump : (size_t)0))
    UnitG cur, nxt; LaneVA cva, nva; int ui = 0;
    if (!S.next(0, cur, cva)) return;
    f32x4 acc[2][2][4][2];
#pragma unroll
    for (int a = 0; a < 2; ++a)
#pragma unroll
        for (int b = 0; b < 2; ++b)
#pragma unroll
            for (int m = 0; m < 4; ++m)
#pragma unroll
                for (int n = 0; n < 2; ++n) acc[a][b][m][n] = (f32x4){0.f, 0.f, 0.f, 0.f};
    bf16x8 At[4][2], B0[2][2], B1[2][2];
    {
        const char* cA = cur.a0; const char* cB = cur.b0;
        PG8_STAGE_B(PG8_SB(0, 0), cB); PG8_STAGE_B(PG8_SB(0, 1), cB + hstepB); PG8_STAGE_A(PG8_SA(0, 0), cA, 0, cva); PG8_STAGE_A(PG8_SA(0, 1), cA, 1, cva);
        if (wr == 1) PG8_BAR;
        PG8_WAIT_V(2); PG8_BAR;
        PG8_STAGE_B(PG8_SB(1, 0), cB + kstep); PG8_STAGE_A(PG8_SA(1, 0), cA + kstep, 0, cva); PG8_STAGE_B(PG8_SB(1, 1), cB + hstepB + kstep);
        PG8_WAIT_V(6); PG8_BAR;
    }
    for (;;) {
        const bool has_next = S.next(ui + 1, nxt, nva);
        if (!has_next) { nxt = cur; if constexpr (GA) nva = cva; }
        const char* nA = nxt.a0; const char* nB = nxt.b0;
        for (int t = 0; t < nt; t += 2) {
            const bool last = (t == nt - 2);
            const char* a1 = cur.a0 + (size_t)(t + 1) * kstep;
            const char* a2 = last ? nA : cur.a0 + (size_t)(t + 2) * kstep; const char* b2 = last ? nB : PG8_BPTR(cur, t + 2);
            const char* a3 = a2 + kstep; const char* b3 = b2 + kstep;
            LaneVA va2;
            if constexpr (GA) {
#pragma unroll
                for (int h = 0; h < 2; ++h)
#pragma unroll
                    for (int i = 0; i < 2; ++i) va2.v[h][i] = last ? nva.v[h][i] : cva.v[h][i];
            }
            PG8_LDB(B0, 0, 0); PG8_LDB(B1, 0, 1); SBAR(); PG8_LDA(At, 0, 0); PG8_STAGE_A(PG8_SA(1, 1), a1, 1, cva);
            PG8_WAIT_V(8); PG8_WAIT_L(0); PG8_BAR; PG8_MMA(0, 0, At, B0); PG8_MMA(0, 1, At, B1); PG8_BAR; SBAR();
            PG8_LDA(At, 0, 1); PG8_STAGE_B(PG8_SB(0, 0), b2); PG8_STAGE_B(PG8_SB(0, 1), b2 + hstepB); PG8_STAGE_A(PG8_SA(0, 0), a2, 0, va2);
            PG8_WAIT_V(8); PG8_WAIT_L(0); PG8_BAR; PG8_MMA(1, 0, At, B0); PG8_MMA(1, 1, At, B1); PG8_BAR; SBAR();
            PG8_LDB(B0, 1, 0); PG8_LDB(B1, 1, 1); SBAR(); PG8_LDA(At, 1, 0); PG8_STAGE_A(PG8_SA(0, 1), a2, 1, va2);
            PG8_WAIT_V(8); PG8_WAIT_L(0); PG8_BAR; PG8_MMA(0, 0, At, B0); PG8_MMA(0, 1, At, B1); PG8_BAR; SBAR();
            PG8_LDA(At, 1, 1); PG8_STAGE_B(PG8_SB(1, 0), b3); PG8_STAGE_B(PG8_SB(1, 1), b3 + hstepB); PG8_STAGE_A(PG8_SA(1, 0), a3, 0, va2);
            PG8_WAIT_V(8); PG8_WAIT_L(0); PG8_BAR; PG8_MMA(1, 0, At, B0); PG8_MMA(1, 1, At, B1); PG8_BAR; SBAR();
        }
        if (wr == 0) PG8_BAR;
        E(acc, cur, wr, wc, fr, fq);
        if (!has_next) break;
#pragma unroll
        for (int a = 0; a < 2; ++a)
#pragma unroll
            for (int b = 0; b < 2; ++b)
#pragma unroll
                for (int m = 0; m < 4; ++m)
#pragma unroll
                    for (int n = 0; n < 2; ++n) acc[a][b][m][n] = (f32x4){0.f, 0.f, 0.f, 0.f};
        cur = nxt; if constexpr (GA) cva = nva; ++ui;
        if (wr == 1) PG8_BAR;
    }
    PG8_WAIT_V(0);
    PG8_BAR;
#undef PG8_SA
#undef PG8_SB
#undef PG8_LD1
#undef PG8_STAGE_A
#undef PG8_STAGE_B
#undef PG8_LDA
#undef PG8_LDB
#undef PG8_MMA
#undef PG8_WAIT_V
#undef PG8_WAIT_L
#undef PG8_BAR
#undef PG8_BPTR
}

__device__ __forceinline__ u32x4 pack8(const f32x4& v0, const f32x4& v1, float s) {
    u32x4 w; w.x = cvtpk(v0[0] * s, v0[1] * s); w.y = cvtpk(v0[2] * s, v0[3] * s); w.z = cvtpk(v1[0] * s, v1[1] * s); w.w = cvtpk(v1[2] * s, v1[3] * s); return w;
}
struct EpiQKV {
    bf16_t* Q; float qscale;
    __device__ __forceinline__ void operator()(const f32x4 (&acc)[2][2][4][2], const UnitG& u, int wr, int wc, int fr, int fq) const {
        const int t = u.pn >> 2; bf16_t* base = Q + (size_t)t * T * D; const float sc = (t == 0) ? qscale : 1.f;
        const int col0 = (u.pn & 3) * BM + wc * 32 + 8 * fq, row0 = u.pm * BM + wr * 64 + fr;
#pragma unroll
        for (int ai = 0; ai < 2; ++ai)
#pragma unroll
            for (int m = 0; m < 4; ++m) { bf16_t* rowp = base + (size_t)(row0 + ai * HALF + m * 16) * D + col0;
#pragma unroll
                for (int bj = 0; bj < 2; ++bj) *(u32x4*)(rowp + bj * HALF) = pack8(acc[ai][bj][m][0], acc[ai][bj][m][1], sc); }
    }
};
struct EpiY {
    bf16_t* Y;
    __device__ __forceinline__ void operator()(const f32x4 (&acc)[2][2][4][2], const UnitG& u, int wr, int wc, int fr, int fq) const {
        const int col0 = u.pn * BM + wc * 32 + 8 * fq, row0 = u.pm * BM + wr * 64 + fr;
#pragma unroll
        for (int ai = 0; ai < 2; ++ai)
#pragma unroll
            for (int m = 0; m < 4; ++m) { bf16_t* rowp = Y + (size_t)(row0 + ai * HALF + m * 16) * D + col0;
#pragma unroll
                for (int bj = 0; bj < 2; ++bj) *(u32x4*)(rowp + bj * HALF) = pack8(acc[ai][bj][m][0], acc[ai][bj][m][1], 1.f); }
    }
};
struct EpiRet {
    bf16_t *RQ, *RK, *RV, *RG; const f32x2* CS;
    __device__ __forceinline__ void operator()(const f32x4 (&acc)[2][2][4][2], const UnitG& u, int wr, int wc, int fr, int fq) const {
        const int row0 = u.pm * BM + wr * 64 + fr;
        if (u.pn >= 8) {
            bf16_t* base = (u.pn >= 16) ? RG : RV; const int col0 = (u.pn & 7) * BM + wc * 32 + 8 * fq;
#pragma unroll
            for (int ai = 0; ai < 2; ++ai)
#pragma unroll
                for (int m = 0; m < 4; ++m) { bf16_t* rowp = base + (size_t)(row0 + ai * HALF + m * 16) * 2048 + col0;
#pragma unroll
                    for (int bj = 0; bj < 2; ++bj) *(u32x4*)(rowp + bj * HALF) = pack8(acc[ai][bj][m][0], acc[ai][bj][m][1], 1.f); }
        } else {
            const bool isk = u.pn >= 4; const int head = 2 * (u.pn & 3) + (wc >> 1), jb = (wc & 1) * 32 + 8 * fq;
            const float lg = __builtin_log2f(1.0f - __builtin_exp2f(-5.0f - (float)head));
            bf16_t* base = (isk ? RK : RQ) + head * 128 + jb;
#pragma unroll
            for (int ai = 0; ai < 2; ++ai)
#pragma unroll
                for (int m = 0; m < 4; ++m) {
                    const int row = row0 + ai * HALF + m * 16; const float np1 = (float)((row & 127) + 1);
                    const float fac = isk ? 0.08838834764831845f * __builtin_exp2f(-np1 * lg) : __builtin_exp2f(np1 * lg);
                    const f32x4* cs = (const f32x4*)(CS + (size_t)row * 64 + jb);
                    const f32x4 c01 = cs[0], c23 = cs[1], c45 = cs[2], c67 = cs[3];
                    const f32x4 x1a = acc[ai][0][m][0], x1b = acc[ai][0][m][1], x2a = acc[ai][1][m][0], x2b = acc[ai][1][m][1];
                    f32x4 o1a, o1b, o2a, o2b;
                    o1a[0] = x1a[0] * c01[0] - x2a[0] * c01[1]; o2a[0] = x2a[0] * c01[0] + x1a[0] * c01[1];
                    o1a[1] = x1a[1] * c01[2] - x2a[1] * c01[3]; o2a[1] = x2a[1] * c01[2] + x1a[1] * c01[3];
                    o1a[2] = x1a[2] * c23[0] - x2a[2] * c23[1]; o2a[2] = x2a[2] * c23[0] + x1a[2] * c23[1];
                    o1a[3] = x1a[3] * c23[2] - x2a[3] * c23[3]; o2a[3] = x2a[3] * c23[2] + x1a[3] * c23[3];
                    o1b[0] = x1b[0] * c45[0] - x2b[0] * c45[1]; o2b[0] = x2b[0] * c45[0] + x1b[0] * c45[1];
                    o1b[1] = x1b[1] * c45[2] - x2b[1] * c45[3]; o2b[1] = x2b[1] * c45[2] + x1b[1] * c45[3];
                    o1b[2] = x1b[2] * c67[0] - x2b[2] * c67[1]; o2b[2] = x2b[2] * c67[0] + x1b[2] * c67[1];
                    o1b[3] = x1b[3] * c67[2] - x2b[3] * c67[3]; o2b[3] = x2b[3] * c67[2] + x1b[3] * c67[3];
                    bf16_t* rowp = base + (size_t)row * D;
                    *(u32x4*)(rowp) = pack8(o1a, o1b, fac); *(u32x4*)(rowp + 64) = pack8(o2a, o2b, fac);
                }
        }
    }
};
__device__ __forceinline__ float silu_f(float x) { return x * __builtin_amdgcn_rcpf(1.0f + __builtin_exp2f(-x * LOG2E)); }
struct EpiUp {
    bf16_t* HID; const f32x2* WTS;
    __device__ __forceinline__ void operator()(const f32x4 (&acc)[2][2][4][2], const UnitG& u, int wr, int wc, int fr, int fq) const {
        const int ct = u.pn, wsel = ct >> 2, col0 = wsel * 512 + (ct & 3) * 128 + wc * 32 + 8 * fq;
#pragma unroll
        for (int ai = 0; ai < 2; ++ai)
#pragma unroll
            for (int m = 0; m < 4; ++m) {
                const int r = ai * HALF + wr * 64 + m * 16 + fr;
                if (r < u.x1) {
                    const f32x2 w2 = WTS[u.x0 + r]; const float w = wsel ? w2.y : w2.x;
                    const f32x4 g0 = acc[ai][0][m][0], g1 = acc[ai][0][m][1], u0 = acc[ai][1][m][0], u1 = acc[ai][1][m][1];
                    f32x4 h0, h1;
#pragma unroll
                    for (int i = 0; i < 4; ++i) { h0[i] = silu_f(g0[i]) * u0[i]; h1[i] = silu_f(g1[i]) * u1[i]; }
                    *(u32x4*)(HID + (size_t)(u.pm * BM + r) * D + col0) = pack8(h0, h1, w);
                }
            }
    }
};
struct EpiDown {
    bf16_t* Y; const int* LIST;
    __device__ __forceinline__ void operator()(const f32x4 (&acc)[2][2][4][2], const UnitG& u, int wr, int wc, int fr, int fq) const {
        const int col0 = u.pn * BM + wc * 32 + 8 * fq;
#pragma unroll
        for (int ai = 0; ai < 2; ++ai)
#pragma unroll
            for (int m = 0; m < 4; ++m) {
                const int r = ai * HALF + wr * 64 + m * 16 + fr;
                if (r < u.x1) {
                    const int tok = LIST[u.x0 + r]; bf16_t* rowp = Y + (size_t)tok * D + col0;
#pragma unroll
                    for (int bj = 0; bj < 2; ++bj) *(u32x4*)(rowp + bj * HALF) = pack8(acc[ai][bj][m][0], acc[ai][bj][m][1], 1.f);
                }
            }
    }
};
}

constexpr size_t MiB = 1u << 20;
constexpr size_t WS_CTL = 0, ZERO_BYTES = 1 * MiB;
constexpr size_t WS_CS = 2 * MiB;
constexpr size_t WS_WQKV = 18 * MiB, WS_WSO = 30 * MiB, WS_WRI = 34 * MiB, WS_WRO = 58 * MiB;
constexpr size_t WS_WGU = 66 * MiB, WS_WD = 98 * MiB;
constexpr size_t WS_XN = 114 * MiB;
constexpr size_t WS_PROJ = 178 * MiB;
constexpr size_t WS_LIST = 562 * MiB, WS_WTS = 565 * MiB, WS_ADAP = 571 * MiB, WS_END = 577 * MiB;
constexpr size_t PJ_Q = 0, PJ_K = 64 * MiB, PJ_V = 128 * MiB;
constexpr size_t PJ_RQ = 0, PJ_RK = 64 * MiB, PJ_RV = 128 * MiB, PJ_RG = 256 * MiB;
constexpr size_t PJ_HID = 0, PJ_Y2 = 128 * MiB;
constexpr int CW_BAR = 4096, CW_GCNT = 16384;
constexpr int RING_BYTES = 131072, LDSCTL_OFF = RING_BYTES, TBL_OFF = RING_BYTES + 1024, LDS_BYTES = 147456;
constexpr int MAXU = 6;

#define XB_TMO      128
#define XB_XCNT(j)  (256  + 64 * (j))
#define XB_XSUB(j)  (1280 + 64 * (j))
#define XB_XGEN(j)  (2304 + 64 * (j))
#define XB_TOP      3328
#define XB_TOPGEN   3392
#define XCD_BAR_WORDS 3456
#define XB_SPIN_CAP (1u << 18)
__device__ __forceinline__ unsigned xb_ld(unsigned* p)              { return __hip_atomic_load(p, __ATOMIC_RELAXED, __HIP_MEMORY_SCOPE_AGENT); }
__device__ __forceinline__ unsigned xb_add(unsigned* p, unsigned v) { return __hip_atomic_fetch_add(p, v, __ATOMIC_RELAXED, __HIP_MEMORY_SCOPE_AGENT); }
__device__ __forceinline__ unsigned xb_xcc_id() { return (unsigned)__builtin_amdgcn_s_getreg((3 << 11) | 20) & 0xFu; }
#define XB_SPIN(cond, bar) do { unsigned _sp = 0; while (cond) { __builtin_amdgcn_s_sleep(1); \
    if ((++_sp & 255u) == 0u) { if (xb_ld(&(bar)[XB_TMO])) break; if (_sp > XB_SPIN_CAP) { atomicAdd(&(bar)[XB_TMO], 1u); break; } } } } while (0)
struct XcdBarrier { unsigned* bar; unsigned x; volatile LAS unsigned* st; };
__device__ __forceinline__ XcdBarrier xcd_barrier_post(unsigned* bar, volatile LAS unsigned* st) {
    XcdBarrier b; b.bar = bar; b.x = xb_xcc_id(); b.st = st;
    if (threadIdx.x == 0) (void)xb_add(&bar[XB_XCNT(b.x)], 1u);
    return b;
}
__device__ __forceinline__ void xcd_barrier_complete(unsigned* bar, unsigned x, unsigned& nloc, unsigned& nx) {
    const unsigned G = gridDim.x * gridDim.y * gridDim.z;
    unsigned sum, cnt, mine, sp = 0u;
    for (;;) {
        sum = 0u; cnt = 0u; mine = 0u;
#pragma unroll
        for (unsigned j = 0; j < 16; ++j) { const unsigned c = xb_ld(&bar[XB_XCNT(j)]); sum += c; cnt += (c > 0u) ? 1u : 0u; mine = (j == x) ? c : mine; }
        if (sum == G) break;
        __builtin_amdgcn_s_sleep(1);
        if ((++sp & 255u) == 0u) { if (xb_ld(&bar[XB_TMO])) break; if (sp > XB_SPIN_CAP) { atomicAdd(&bar[XB_TMO], 1u); break; } }
    }
    nloc = mine > 0u ? mine : 1u; nx = cnt > 0u ? cnt : 1u;
}
__device__ __forceinline__ void xcd_barrier(const XcdBarrier& b) {
    asm volatile("s_waitcnt vmcnt(0)" ::: "memory");
    __syncthreads();
    if (threadIdx.x == 0) {
        unsigned* bar = b.bar;
        __builtin_amdgcn_s_waitcnt(0);
        unsigned nloc = b.st[0], nx = b.st[1];
        if (nloc == 0u) { xcd_barrier_complete(bar, b.x, nloc, nx); b.st[0] = nloc; b.st[1] = nx; }
        const unsigned old = xb_add(&bar[XB_XSUB(b.x)], 1u);
        const unsigned gen = old / nloc;
        if (old + 1u == (gen + 1u) * nloc) {
            __builtin_amdgcn_fence(__ATOMIC_RELEASE, "agent");
            asm volatile("s_waitcnt vmcnt(0)" ::: "memory");
            const unsigned og = xb_add(&bar[XB_TOP], 1u);
            const unsigned tg = og / nx;
            if (og + 1u == (tg + 1u) * nx) xb_add(&bar[XB_TOPGEN], 1u);
            else XB_SPIN(xb_ld(&bar[XB_TOPGEN]) == tg, bar);
            __builtin_amdgcn_fence(__ATOMIC_ACQUIRE, "agent");
            xb_add(&bar[XB_XGEN(b.x)], 1u);
            asm volatile("s_waitcnt vmcnt(0)" ::: "memory");
        } else {
            XB_SPIN(xb_ld(&bar[XB_XGEN(b.x)]) == gen, bar);
            __builtin_amdgcn_fence(__ATOMIC_ACQUIRE, "agent");
            asm volatile("s_waitcnt vmcnt(0)" ::: "memory");
        }
    }
    __syncthreads();
}

typedef const __attribute__((address_space(4))) unsigned long long* kptr_t;
__device__ __forceinline__ const void* kin(int k) { kptr_t p = (kptr_t)__builtin_amdgcn_kernarg_segment_ptr(); asm volatile("" : "+s"(p)); return (const void*)p[k]; }
struct Frame {
    LAS unsigned char* lds; unsigned char* ws; unsigned* ctl;
    int tid, lane, wave, wave0, vcu, G, bx;
    float* out;
};
__device__ __forceinline__ float shx(float v, int o, int lane) { return __int_as_float(__builtin_amdgcn_ds_bpermute((lane ^ o) << 2, __float_as_int(v))); }
__device__ __forceinline__ float wave_sum(float v, int lane) {
#pragma unroll
    for (int o = 1; o < 64; o <<= 1) v += shx(v, o, lane);
    return v;
}
__device__ __forceinline__ void tr_item(const float* Wsrc, int ldw, bf16_t* dst, int ldd, LAS float* scr, int lane) {
#pragma unroll 8
    for (int i = 0; i < 32; ++i) { const int kk = 2 * i + (lane >> 5); scr[kk * 33 + (lane & 31)] = Wsrc[(size_t)kk * ldw + (lane & 31)]; }
    LDS_WAIT(); asm volatile("" ::: "memory");
    const int c = lane & 7;
#pragma unroll
    for (int j = 0; j < 4; ++j) { const int n = (lane >> 3) + 8 * j; const LAS float* s = scr + (8 * c) * 33 + n;
        u32x4 o; o.x = cvtpk(s[0 * 33], s[1 * 33]); o.y = cvtpk(s[2 * 33], s[3 * 33]); o.z = cvtpk(s[4 * 33], s[5 * 33]); o.w = cvtpk(s[6 * 33], s[7 * 33]);
        *(GAS u32x4*)(dst + (size_t)n * ldd + 8 * c) = o; }
    LDS_WAIT(); asm volatile("" ::: "memory");
}
__device__ __forceinline__ void mixer_weight_item(Frame& F, int it, LAS float* scr) {
    const int half = it / 6144; int r = it % 6144; const int l = half;
    if (r < 1536) { const int kb = r / 96, nb = r % 96;
        tr_item(((const float*)kin(7)) + (size_t)l * 1024 * 3072 + (size_t)kb * 64 * 3072 + nb * 32, 3072, (bf16_t*)(F.ws + WS_WQKV) + (size_t)l * 3072 * 1024 + (size_t)nb * 32 * 1024 + kb * 64, 1024, scr, F.lane); return; }
    r -= 1536;
    if (r < 512) { const int kb = r / 32, nb = r % 32;
        tr_item(((const float*)kin(8)) + (size_t)l * 1024 * 1024 + (size_t)kb * 64 * 1024 + nb * 32, 1024, (bf16_t*)(F.ws + WS_WSO) + (size_t)l * 1024 * 1024 + (size_t)nb * 32 * 1024 + kb * 64, 1024, scr, F.lane); return; }
    r -= 512;
    if (r < 3072) { const int kb = r / 192, nb = r % 192; const int s = nb * 32;
        int drow = s;
        if (s < 2048) { const int seg = s >> 10, head = (s >> 7) & 7, x2 = (s >> 6) & 1, j = s & 63; drow = (seg * 4 + (head >> 1)) * 256 + (x2 * 2 + (head & 1)) * 64 + j; }
        tr_item(((const float*)kin(9)) + (size_t)l * 1024 * 6144 + (size_t)kb * 64 * 6144 + s, 6144, (bf16_t*)(F.ws + WS_WRI) + (size_t)l * 6144 * 1024 + (size_t)drow * 1024 + kb * 64, 1024, scr, F.lane); return; }
    r -= 3072;
    { const int kb = r / 32, nb = r % 32;
        tr_item(((const float*)kin(11)) + (size_t)l * 2048 * 1024 + (size_t)kb * 64 * 1024 + nb * 32, 1024, (bf16_t*)(F.ws + WS_WRO) + (size_t)l * 1024 * 2048 + (size_t)nb * 32 * 2048 + kb * 64, 2048, scr, F.lane); }
}
__device__ __forceinline__ void moe_weight_item(Frame& F, int layer, int it, LAS float* scr) {
    const int kind = it / 4096, r = it % 4096, e = r / 256, q = r % 256;
    if (kind < 2) { const int kb = q / 16, nb = q % 16, f = nb * 32; const int drow = (f >> 7) * 256 + kind * 128 + (f & 127);
        const float* W = (kind == 0 ? ((const float*)kin(14)) : ((const float*)kin(15))) + ((size_t)(layer * 16 + e) * 1024 + (size_t)kb * 64) * 512 + f;
        tr_item(W, 512, (bf16_t*)(F.ws + WS_WGU) + ((size_t)e * 1024 + drow) * 1024 + kb * 64, 1024, scr, F.lane);
    } else { const int kb = q / 32, nb = q % 32;
        const float* W = ((const float*)kin(16)) + ((size_t)(layer * 16 + e) * 512 + (size_t)kb * 64) * 1024 + nb * 32;
        tr_item(W, 1024, (bf16_t*)(F.ws + WS_WD) + ((size_t)(e >> 2) * 1024 + nb * 32) * 2048 + (e & 3) * 512 + kb * 64, 2048, scr, F.lane); }
}
__device__ __forceinline__ void moe_weight_phase(Frame& F, int layer) {
    __syncthreads();
    LAS float* scr = (LAS float*)(F.lds + F.wave * 8448);
    const int gw = F.vcu * 8 + F.wave, NGW = F.G * 8;
    for (int it = gw; it < 12288; it += NGW) moe_weight_item(F, layer, it, scr);
}

__device__ __forceinline__ void p0_prologue(Frame& F) {
    LAS float* sc = (LAS float*)F.lds;
    for (int i = F.tid; i < 8 * 1024; i += 512) { const float v = ((const float*)kin(1))[i]; sc[i] = v / (1.0f + __expf(-v)); }
    __syncthreads();
    const int gw = F.vcu * 8 + F.wave, NGW = F.G * 8;
    float* ADAP = (float*)(F.ws + WS_ADAP);
    for (int it = gw; it < 8 * 48 * 8; it += NGW) {
        const int ks = it & 7, cg = (it >> 3) % 48, j = it / 384;
        const float* W = ((const float*)kin(3)) + ((size_t)j * 1024 + ks * 128) * 3072 + cg * 64 + F.lane;
        float a[8] = {0.f, 0.f, 0.f, 0.f, 0.f, 0.f, 0.f, 0.f};
        for (int k0 = 0; k0 < 128; k0 += 8) {
            float w[8];
#pragma unroll
            for (int u = 0; u < 8; ++u) w[u] = W[(size_t)(k0 + u) * 3072];
#pragma unroll
            for (int u = 0; u < 8; ++u)
#pragma unroll
                for (int b = 0; b < 8; ++b) a[b] += sc[b * 1024 + ks * 128 + k0 + u] * w[u];
        }
#pragma unroll
        for (int b = 0; b < 8; ++b) ADAP[((size_t)(ks * 8 + j) * 8 + b) * 3072 + cg * 64 + F.lane] = a[b];
    }
    LAS float* scr = (LAS float*)(F.lds + 32768 + F.wave * 8448);
    for (int it = gw; it < 12288; it += NGW) mixer_weight_item(F, it, scr);
    f32x2* CS = (f32x2*)(F.ws + WS_CS);
    const float invf = 1.0f / __powf(10000.0f, (float)(2 * F.lane) * (1.0f / 128.0f));
    for (int row = gw; row < T; row += NGW) {
        const float ang = (float)((const int*)kin(2))[row] * invf;
        const double rev = (double)ang * 0.15915494309189535; const float fr = (float)(rev - floor(rev));
        CS[(size_t)row * 64 + F.lane] = (f32x2){__builtin_amdgcn_cosf(fr), __builtin_amdgcn_sinf(fr)};
    }
}
__device__ __forceinline__ void load_mod(Frame& F, int j, int b, int which, f32x4 (&v)[4]) {
    const float* ADAP = (const float*)(F.ws + WS_ADAP) + (size_t)(j * 8 + b) * 3072 + which * 1024; const float* bb = ((const float*)kin(4)) + (size_t)j * 3072 + which * 1024;
#pragma unroll
    for (int jj = 0; jj < 4; ++jj) { f32x4 a = *(const f32x4*)(ADAP + 256 * jj + 4 * F.lane);
#pragma unroll 1
        for (int ks = 1; ks < 8; ++ks) a = a + *(const f32x4*)(ADAP + (size_t)ks * 64 * 3072 + 256 * jj + 4 * F.lane);
        const f32x4 c = *(const f32x4*)(bb + 256 * jj + 4 * F.lane); v[jj] = a + c + (which ? 1.0f : 0.0f); }
}
__device__ __forceinline__ void p1_mod0(Frame& F) {
    const int row0 = F.vcu * (T / F.G), b = row0 / SEQ; bf16_t* XN = (bf16_t*)(F.ws + WS_XN);
    f32x4 sh[4], sc[4]; load_mod(F, 0, b, 0, sh); load_mod(F, 0, b, 1, sc);
    for (int r = F.wave; r < T / F.G; r += 8) { const size_t row = row0 + r;
#pragma unroll
        for (int jj = 0; jj < 4; ++jj) { const f32x4 xv = *(const f32x4*)(((const float*)kin(0)) + row * D + 256 * jj + 4 * F.lane); const f32x4 h = xv * sc[jj] + sh[jj];
            u32x2 w; w.x = cvtpk(h[0], h[1]); w.y = cvtpk(h[2], h[3]); *(u32x2*)(XN + row * D + 256 * jj + 4 * F.lane) = w; } }
}

__device__ __forceinline__ void ln_phase(Frame& F, const float* xbase, const bf16_t* Y, int j, int jn, bool router, int layer) {
    const int RPW = T / F.G;
    const int row0 = F.vcu * RPW, b = row0 / SEQ; bf16_t* XN = (bf16_t*)(F.ws + WS_XN);
    LAS float* rwT = (LAS float*)F.lds;
    LAS int* lhist = (LAS int*)(F.lds + 65536); LAS int* gbase = lhist + 32; LAS int* rinfo = lhist + 64;
    if (router) {
        for (int i = F.tid; i < 16 * 1024; i += 512) { const int e = i >> 10, d = i & 1023; rwT[i] = ((const float*)kin(12))[d * 16 + e]; }
        if (F.tid < 32) lhist[F.tid] = 0;
    }
    __syncthreads();
    f32x4 gt[4], lg[4], lb[4], sh[4], sc[4];
    load_mod(F, j, b, 2, gt);
#pragma unroll
    for (int jj = 0; jj < 4; ++jj) { lg[jj] = *(const f32x4*)(((const float*)kin(5)) + (size_t)j * 1024 + 256 * jj + 4 * F.lane); lb[jj] = *(const f32x4*)(((const float*)kin(6)) + (size_t)j * 1024 + 256 * jj + 4 * F.lane); }
    if (jn >= 0) { load_mod(F, jn, b, 0, sh); load_mod(F, jn, b, 1, sc); }
    for (int r = F.wave; r < RPW; r += 8) {
        const size_t row = row0 + r;
        f32x4 v[4]; float s = 0.f;
#pragma unroll
        for (int jj = 0; jj < 4; ++jj) { const f32x4 xv = *(const f32x4*)(xbase + row * D + 256 * jj + 4 * F.lane); const u32x2 yw = *(const u32x2*)(Y + row * D + 256 * jj + 4 * F.lane);
            const f32x4 yv = {bflo(yw.x), bfhi(yw.x), bflo(yw.y), bfhi(yw.y)};
            v[jj] = xv * DN_ALPHA + gt[jj] * yv; s += (v[jj][0] + v[jj][1]) + (v[jj][2] + v[jj][3]); }
        const float mean = wave_sum(s, F.lane) * (1.f / D); float s2 = 0.f;
#pragma unroll
        for (int jj = 0; jj < 4; ++jj) { v[jj] = v[jj] - mean; s2 += (v[jj][0] * v[jj][0] + v[jj][1] * v[jj][1]) + (v[jj][2] * v[jj][2] + v[jj][3] * v[jj][3]); }
        const float rstd = 1.f / sqrtf(wave_sum(s2, F.lane) * (1.f / D) + LN_EPS);
#pragma unroll
        for (int jj = 0; jj < 4; ++jj) { v[jj] = v[jj] * rstd * lg[jj] + lb[jj]; *(f32x4*)(F.out + row * D + 256 * jj + 4 * F.lane) = v[jj]; }
        if (jn >= 0) {
#pragma unroll
            for (int jj = 0; jj < 4; ++jj) { v[jj] = v[jj] * sc[jj] + sh[jj]; u32x2 w; w.x = cvtpk(v[jj][0], v[jj][1]); w.y = cvtpk(v[jj][2], v[jj][3]); *(u32x2*)(XN + row * D + 256 * jj + 4 * F.lane) = w; }
        }
        if (router) {
            float lgt[16];
#pragma unroll
            for (int e = 0; e < 16; ++e) { float a = 0.f;
#pragma unroll
                for (int jj = 0; jj < 4; ++jj) { const f32x4 w = *(const LAS f32x4*)(rwT + e * 1024 + 256 * jj + 4 * F.lane); a += (v[jj][0] * w[0] + v[jj][1] * w[1]) + (v[jj][2] * w[2] + v[jj][3] * w[3]); }
                lgt[e] = wave_sum(a, F.lane) + ((const float*)kin(13))[e]; }
            float mx = lgt[0];
#pragma unroll
            for (int e = 1; e < 16; ++e) mx = fmaxf(mx, lgt[e]);
            float bestsc = -1.f; int sel = 0;
#pragma unroll
            for (int g = 0; g < 4; ++g) { float p1 = -1.f, p2 = -1.f;
#pragma unroll
                for (int i = 0; i < 4; ++i) { const float p = __expf(lgt[4 * g + i] - mx); if (p > p1) { p2 = p1; p1 = p; } else if (p > p2) p2 = p; }
                const float scg = p1 + p2; if (scg > bestsc) { bestsc = scg; sel = g; } }
            float l4[4];
#pragma unroll
            for (int i = 0; i < 4; ++i) { l4[i] = lgt[i]; if (sel == 1) l4[i] = lgt[4 + i]; if (sel == 2) l4[i] = lgt[8 + i]; if (sel == 3) l4[i] = lgt[12 + i]; }
            int i1 = 0; float v1 = l4[0];
#pragma unroll
            for (int i = 1; i < 4; ++i) if (l4[i] > v1) { v1 = l4[i]; i1 = i; }
            int i2 = -1; float v2 = -INFINITY;
#pragma unroll
            for (int i = 0; i < 4; ++i) if (i != i1 && (i2 < 0 || l4[i] > v2)) { v2 = l4[i]; i2 = i; }
            const float w1 = 1.0f / (1.0f + __expf(v2 - v1)), w2 = 1.0f - w1;
            const int la = i1 < i2 ? i1 : i2, lbx = i1 < i2 ? i2 : i1; const float wa = i1 < i2 ? w1 : w2, wb = i1 < i2 ? w2 : w1;
            const int pair = (la == 0) ? (lbx - 1) : (la == 1 ? lbx + 1 : 5);
            const int bucket = sel * 6 + pair;
            if (F.lane == 0) { const int rank = __hip_atomic_fetch_add(lhist + bucket, 1, __ATOMIC_RELAXED, __HIP_MEMORY_SCOPE_WORKGROUP);
                rinfo[r * 4 + 0] = bucket; rinfo[r * 4 + 1] = rank; rinfo[r * 4 + 2] = __float_as_int(wa); rinfo[r * 4 + 3] = __float_as_int(wb); }
        }
    }
    if (router) {
        __syncthreads();
        unsigned* gcnt = F.ctl + CW_GCNT + layer * 64;
        if (F.tid < NBUCKET) gbase[F.tid] = (int)__hip_atomic_fetch_add(gcnt + F.tid, (unsigned)lhist[F.tid], __ATOMIC_RELAXED, __HIP_MEMORY_SCOPE_AGENT);
        __syncthreads();
        int* LIST = (int*)(F.ws + WS_LIST); f32x2* WTS = (f32x2*)(F.ws + WS_WTS);
        for (int r = F.tid; r < RPW; r += 512) { const int bucket = rinfo[r * 4 + 0], pos = gbase[bucket] + rinfo[r * 4 + 1];
            LIST[(size_t)bucket * T + pos] = row0 + r; WTS[(size_t)bucket * T + pos] = (f32x2){__int_as_float(rinfo[r * 4 + 2]), __int_as_float(rinfo[r * 4 + 3])}; }
    }
}

__device__ __forceinline__ void gate_phase(Frame& F, int rl) {
    bf16_t* RV = (bf16_t*)(F.ws + WS_PROJ + PJ_RV); const bf16_t* RG = (const bf16_t*)(F.ws + WS_PROJ + PJ_RG);
    const float* gn = ((const float*)kin(10)) + (size_t)rl * 2048;
    const int gw = F.vcu * 8 + F.wave, NGW = F.G * 8;
    for (int row = gw; row < T; row += NGW) {
#pragma unroll
        for (int jj = 0; jj < 4; ++jj) {
            const size_t off = (size_t)row * 2048 + jj * 512 + F.lane * 8;
            const u32x4 ow = *(const u32x4*)(RV + off), gw4 = *(const u32x4*)(RG + off);
            float o[8] = {bflo(ow.x), bfhi(ow.x), bflo(ow.y), bfhi(ow.y), bflo(ow.z), bfhi(ow.z), bflo(ow.w), bfhi(ow.w)};
            const float g[8] = {bflo(gw4.x), bfhi(gw4.x), bflo(gw4.y), bfhi(gw4.y), bflo(gw4.z), bfhi(gw4.z), bflo(gw4.w), bfhi(gw4.w)};
            float s = 0.f;
#pragma unroll
            for (int i = 0; i < 8; ++i) s += o[i];
#pragma unroll
            for (int m = 1; m < 32; m <<= 1) s += shx(s, m, F.lane);
            const float mu = s * (1.f / 256.f); float q = 0.f;
#pragma unroll
            for (int i = 0; i < 8; ++i) { o[i] -= mu; q += o[i] * o[i]; }
#pragma unroll
            for (int m = 1; m < 32; m <<= 1) q += shx(q, m, F.lane);
            const float rstd = 1.f / sqrtf(q * (1.f / 256.f) + LN_EPS);
            const f32x4 g0 = *(const f32x4*)(gn + jj * 512 + F.lane * 8), g1 = *(const f32x4*)(gn + jj * 512 + F.lane * 8 + 4);
            float r[8];
#pragma unroll
            for (int i = 0; i < 8; ++i) r[i] = o[i] * rstd * (i < 4 ? g0[i] : g1[i - 4]) * gp::silu_f(g[i]);
            u32x4 w; w.x = cvtpk(r[0], r[1]); w.y = cvtpk(r[2], r[3]); w.z = cvtpk(r[4], r[5]); w.w = cvtpk(r[6], r[7]);
            *(u32x4*)(RV + off) = w;
        }
    }
}

namespace sb {
constexpr int SLOTB = 8192, NSLOT = 3, L_K = 0, L_V = NSLOT * SLOTB, L_FLAG = 2 * NSLOT * SLOTB, L_OST = L_FLAG + 256;
__device__ __forceinline__ int crow(int r, int hi) { return (r & 3) + 8 * (r >> 2) + 4 * hi; }
#define SB_WAIT_BAR(N) asm volatile("s_waitcnt vmcnt(" #N ") lgkmcnt(0)\n\ts_barrier" ::: "memory")
__device__ __forceinline__ void unit(int tid, int b, int h, int qb, const bf16_t* Q, const bf16_t* K, const bf16_t* V, bf16_t* O, LAS unsigned char* lds) {
    const int lane = tid & 63, r32 = lane & 31, hi = lane >> 5; const int wid = __builtin_amdgcn_readfirstlane(tid >> 6);
    const long rowbase = (long)b * SEQ; const int q0 = qb * 256;
    const bf16_t* Qw = Q + (rowbase + q0 + wid * 32) * D + h * 64;
    const bf16_t* Kh = K + rowbase * D + h * 64; const bf16_t* Vh = V + rowbase * D + h * 64;
    const bf16_t* ksrc = Kh + (long)lane * D + wid * 8;
    const bf16_t* vsrc = Vh + (long)(16 * (wid & 3) + (lane >> 2)) * D + (wid >> 2) * 32 + (lane & 3) * 8;
#define SB_DMA(t, slot) do { \
        __builtin_amdgcn_global_load_lds((const unsigned*)(ksrc + (long)(t) * 64 * D), (LAS unsigned*)(lds + L_K + (slot) * SLOTB + wid * 1024), 16, 0, 0); \
        __builtin_amdgcn_global_load_lds((const unsigned*)(vsrc + (long)(t) * 64 * D), (LAS unsigned*)(lds + L_V + (slot) * SLOTB + wid * 1024), 16, 0, 0); } while (0)
    const int t0 = 4 * qb + 3;
    SB_DMA(t0, 0); if (t0 >= 1) SB_DMA(t0 - 1, 1);
    bf16x8 qr[4];
#pragma unroll
    for (int d0 = 0; d0 < 4; ++d0) qr[d0] = *(const bf16x8*)(Qw + (long)r32 * D + d0 * 16 + hi * 8);
    f32x16 o0 = {}, o1 = {}; float carry = 0.f;
    const int qlo = q0 + 32 * wid, qme = qlo + r32;
    LAS int* flags = (LAS int*)(lds + L_FLAG);
    const LAS unsigned char* kp0 = lds + L_K + hi * 1024 + r32 * 16;
    const unsigned vb0 = (unsigned)(size_t)(lds + L_V) + ((lane >> 4) & 1) * 32 + (lane & 3) * 8 + (4 * hi + ((lane & 15) >> 2)) * 64;
    int sl = 0;
    for (int j = t0; j >= 0; --j) {
        if (j >= 1) SB_WAIT_BAR(2); else SB_WAIT_BAR(0);
        if (j < t0) { const LAS int* fl = flags + ((j + 1) & 1) * 8; int all = 1;
#pragma unroll
            for (int w = 0; w < 8; ++w) all &= fl[w];
            if (__builtin_amdgcn_readfirstlane(all)) break; }
        { const int s2 = (sl >= 1) ? sl - 1 : 2; if (j >= 2) SB_DMA(j - 2, s2); }
        const int kmin = 64 * j;
        if (kmin < qlo + 31) {
            const LAS unsigned char* kp = kp0 + sl * SLOTB;
            f32x16 p0 = {}, p1 = {};
#pragma unroll
            for (int d0 = 0; d0 < 4; ++d0) { const bf16x8 k0 = *(const LAS bf16x8*)(kp + d0 * 2048), k1 = *(const LAS bf16x8*)(kp + d0 * 2048 + 512);
                p0 = __builtin_amdgcn_mfma_f32_32x32x16_bf16(k0, qr[d0], p0, 0, 0, 0); p1 = __builtin_amdgcn_mfma_f32_32x32x16_bf16(k1, qr[d0], p1, 0, 0, 0); }
            f32x16 l0, l1;
#pragma unroll
            for (int r = 0; r < 16; ++r) { p0[r] = fminf(p0[r], 100.f); p1[r] = fminf(p1[r], 100.f);
                l0[r] = -__builtin_amdgcn_logf(1.0f + __builtin_amdgcn_exp2f(p0[r])); l1[r] = -__builtin_amdgcn_logf(1.0f + __builtin_amdgcn_exp2f(p1[r])); }
            if (kmin + 63 >= qlo) {
#pragma unroll
                for (int r = 0; r < 16; ++r) { const int kv = kmin + crow(r, hi);
                    if (kv >= qme) { p0[r] = -INFINITY; l0[r] = 0.f; } if (kv + 32 >= qme) { p1[r] = -INFINITY; l1[r] = 0.f; } }
            }
            float bs[8], pm[8], tt[8];
#pragma unroll
            for (int g = 0; g < 4; ++g) { bs[g] = (l0[4 * g] + l0[4 * g + 1]) + (l0[4 * g + 2] + l0[4 * g + 3]); bs[4 + g] = (l1[4 * g] + l1[4 * g + 1]) + (l1[4 * g + 2] + l1[4 * g + 3]); }
#pragma unroll
            for (int g = 0; g < 8; ++g) { auto rr = __builtin_amdgcn_permlane32_swap(__float_as_uint(bs[g]), __float_as_uint(bs[g]), false, false);
                const float lo = __uint_as_float(rr[0]), up = __uint_as_float(rr[1]); tt[g] = lo + up; pm[g] = hi ? 0.f : up; }
            float sp = carry;
#pragma unroll
            for (int g = 7; g >= 0; --g) {
                const float base = sp + pm[g];
                if (g >= 4) { const int q = 4 * (g - 4); const float c3 = base + l1[q + 3], c2 = c3 + l1[q + 2], c1 = c2 + l1[q + 1], c0 = c1 + l1[q];
                    p1[q + 3] = __builtin_amdgcn_exp2f(p1[q + 3] + c3); p1[q + 2] = __builtin_amdgcn_exp2f(p1[q + 2] + c2); p1[q + 1] = __builtin_amdgcn_exp2f(p1[q + 1] + c1); p1[q] = __builtin_amdgcn_exp2f(p1[q] + c0);
                } else { const int q = 4 * g; const float c3 = base + l0[q + 3], c2 = c3 + l0[q + 2], c1 = c2 + l0[q + 1], c0 = c1 + l0[q];
                    p0[q + 3] = __builtin_amdgcn_exp2f(p0[q + 3] + c3); p0[q + 2] = __builtin_amdgcn_exp2f(p0[q + 2] + c2); p0[q + 1] = __builtin_amdgcn_exp2f(p0[q + 1] + c1); p0[q] = __builtin_amdgcn_exp2f(p0[q] + c0); }
                sp += tt[g];
            }
            carry = sp;
            u32x4 pw0, pw1, pw2, pw3;
            pw0 = (u32x4){cvtpk(p0[0], p0[1]), cvtpk(p0[2], p0[3]), cvtpk(p0[4], p0[5]), cvtpk(p0[6], p0[7])}; pw1 = (u32x4){cvtpk(p0[8], p0[9]), cvtpk(p0[10], p0[11]), cvtpk(p0[12], p0[13]), cvtpk(p0[14], p0[15])};
            pw2 = (u32x4){cvtpk(p1[0], p1[1]), cvtpk(p1[2], p1[3]), cvtpk(p1[4], p1[5]), cvtpk(p1[6], p1[7])}; pw3 = (u32x4){cvtpk(p1[8], p1[9]), cvtpk(p1[10], p1[11]), cvtpk(p1[12], p1[13]), cvtpk(p1[14], p1[15])};
            const unsigned vb = vb0 + sl * SLOTB;
#pragma unroll
            for (int d0 = 0; d0 < 2; ++d0) { s16x4 lo[4], up[4];
#pragma unroll
                for (int ks = 0; ks < 4; ++ks) {
                    asm volatile("ds_read_b64_tr_b16 %0,%1 offset:%c2" : "=&v"(lo[ks]) : "v"(vb), "i"(d0 * 4096 + ks * 1024) : "memory");
                    asm volatile("ds_read_b64_tr_b16 %0,%1 offset:%c2" : "=&v"(up[ks]) : "v"(vb), "i"(d0 * 4096 + ks * 1024 + 512) : "memory"); }
                asm volatile("s_waitcnt lgkmcnt(0)" : "+v"(lo[0]), "+v"(lo[1]), "+v"(lo[2]), "+v"(lo[3]), "+v"(up[0]), "+v"(up[1]), "+v"(up[2]), "+v"(up[3]) :: "memory"); SBAR();
#define SB_PK(k) (bf16x8){lo[k][0], lo[k][1], lo[k][2], lo[k][3], up[k][0], up[k][1], up[k][2], up[k][3]}
                f32x16 oo = d0 ? o1 : o0;
                oo = __builtin_amdgcn_mfma_f32_32x32x16_bf16(__builtin_bit_cast(bf16x8, pw0), SB_PK(0), oo, 0, 0, 0);
                oo = __builtin_amdgcn_mfma_f32_32x32x16_bf16(__builtin_bit_cast(bf16x8, pw1), SB_PK(1), oo, 0, 0, 0);
                oo = __builtin_amdgcn_mfma_f32_32x32x16_bf16(__builtin_bit_cast(bf16x8, pw2), SB_PK(2), oo, 0, 0, 0);
                oo = __builtin_amdgcn_mfma_f32_32x32x16_bf16(__builtin_bit_cast(bf16x8, pw3), SB_PK(3), oo, 0, 0, 0);
                if (d0) o1 = oo; else o0 = oo;
#undef SB_PK
            }
        }
        { const int done = __all(carry < SB_EXIT) ? 1 : 0; if (lane == 0) flags[(j & 1) * 8 + wid] = done; }
        sl = (sl == 2) ? 0 : sl + 1;
    }
    asm volatile("s_waitcnt vmcnt(0) lgkmcnt(0)" ::: "memory");
    bf16_t* Ow = O + (rowbase + q0 + wid * 32) * D + h * 64;
    { LAS bf16_t* stg = (LAS bf16_t*)(lds + L_OST) + wid * 2048;
#pragma unroll
        for (int r = 0; r < 16; ++r) { const int orow = crow(r, hi);
            stg[orow * 64 + r32] = (bf16_t)(cvtpk(o0[r], 0.f) & 0xffffu); stg[orow * 64 + 32 + r32] = (bf16_t)(cvtpk(o1[r], 0.f) & 0xffffu); }
        asm volatile("s_waitcnt lgkmcnt(0)" ::: "memory");
#pragma unroll
        for (int i = 0; i < 4; ++i) { const int row = i * 8 + (lane >> 3), ch = lane & 7; const u32x4 v = *(const LAS u32x4*)(stg + row * 64 + ch * 8); *(u32x4*)(Ow + (long)row * D + ch * 8) = v; } }
    asm volatile("s_waitcnt lgkmcnt(0)\n\ts_barrier" ::: "memory");
#undef SB_DMA
}
}

namespace ret {
constexpr int KV_BYTES = 49152, V_OFF = 32768, ST_OFF = 2 * KV_BYTES, ST_BYTES = 16384;
__device__ __forceinline__ unsigned offb(unsigned row, unsigned ch) { return 256u * row + 16u * (ch ^ (((row & 3) << 2) | ((row >> 2) & 3))); }
__device__ __forceinline__ void unit(int tid, int b, int h, int sl, const bf16_t* RQ, const bf16_t* RK, bf16_t* RV, LAS unsigned char* lds) {
    const int lane = tid & 63, r32 = lane & 31, hi = lane >> 5; const int wid = __builtin_amdgcn_readfirstlane(tid >> 6);
    const int nb = (wid < 4) ? wid : 7 - wid, eb = wid >> 2, db = wid & 3;
    const long rowbase = (long)b * SEQ;
    const float lgam = __builtin_log2f(1.0f - __builtin_exp2f(-5.0f - (float)h)); const float g128 = __builtin_exp2f(128.0f * lgam);
    const int krow = 4 * wid + (lane >> 4), kx = ((lane >> 4) << 2) | (wid & 3);
    const bf16_t* ksrc = RK + (rowbase + krow) * D + h * 128 + (((lane & 15) ^ kx) * 8);
    const bf16_t* vsrc = RV + (rowbase + 16 * wid + (lane >> 2)) * 2048 + h * 256 + sl * 64 + (lane & 3) * 8;
#define RT_DMA(c, buf) do { \
        _Pragma("unroll") for (int k_ = 0; k_ < 4; ++k_) __builtin_amdgcn_global_load_lds((const unsigned*)(ksrc + ((long)(c) * 128 + 32 * k_) * D), (LAS unsigned*)(lds + (buf) * KV_BYTES + (wid + 8 * k_) * 1024), 16, 0, 0); \
        _Pragma("unroll") for (int k_ = 0; k_ < 2; ++k_) __builtin_amdgcn_global_load_lds((const unsigned*)(vsrc + (long)(c) * 128 * 2048 + k_ * 32), (LAS unsigned*)(lds + (buf) * KV_BYTES + V_OFF + k_ * 8192 + wid * 1024), 16, 0, 0); } while (0)
    const bf16_t* qsrc = RQ + (rowbase + 32 * nb + r32) * D + h * 128 + hi * 8;
    bf16x8 qf[8], qn[8];
    RT_DMA(0, 0);
#pragma unroll
    for (int s = 0; s < 8; ++s) qn[s] = *(const bf16x8*)(qsrc + s * 16);
    { LAS u32x4* z = (LAS u32x4*)(lds + ST_OFF + wid * 2048); z[lane] = (u32x4){0u, 0u, 0u, 0u}; z[64 + lane] = (u32x4){0u, 0u, 0u, 0u}; }
    f32x16 st = {};
    const unsigned xr = ((r32 & 3) << 2) | ((r32 >> 2) & 3);
    const unsigned ka0 = 256u * r32 + 16u * ((unsigned)hi ^ xr);
    const unsigned q4 = (lane & 15) >> 2, p4 = lane & 3, blk = (lane >> 4) & 1;
    unsigned kt[2];
#pragma unroll
    for (int t = 0; t < 2; ++t) kt[t] = offb(8 * t + 4 * hi + q4, 4 * db + 2 * blk + (p4 >> 1)) + 8 * (p4 & 1);
    const unsigned vt = V_OFF + eb * 8192 + blk * 32 + p4 * 8 + (4 * hi + q4) * 64;
    const unsigned sa = (32 * eb + r32) * 256;
    const unsigned sx = (unsigned)(r32 & 15);
    const unsigned ldsb = (unsigned)(size_t)lds;
    bf16_t* osrc = RV + (rowbase + 32 * nb) * 2048 + h * 256 + sl * 64 + 32 * eb + r32;
    for (int c = 0; c < SEQ / 128; ++c) {
        const int buf = c & 1;
        asm volatile("s_waitcnt vmcnt(0) lgkmcnt(0)\n\ts_barrier" ::: "memory");
#pragma unroll
        for (int s = 0; s < 8; ++s) qf[s] = qn[s];
        if (c + 1 < SEQ / 128) { RT_DMA(c + 1, buf ^ 1);
#pragma unroll
            for (int s = 0; s < 8; ++s) qn[s] = *(const bf16x8*)(qsrc + (long)(c + 1) * 128 * D + s * 16); }
        const unsigned kvb = ldsb + buf * KV_BYTES;
        f32x16 o = {};
        { const LAS unsigned char* sp = lds + ST_OFF + buf * ST_BYTES + sa;
#pragma unroll
            for (int s = 0; s < 8; ++s) { const bf16x8 sf = *(const LAS bf16x8*)(sp + ((((unsigned)(2 * s + hi)) ^ sx) << 4)); o = __builtin_amdgcn_mfma_f32_32x32x16_bf16(qf[s], sf, o, 0, 0, 0); } }
        for (int mb = 0; mb <= nb; ++mb) {
            f32x16 p = {};
            const LAS unsigned char* kb = lds + buf * KV_BYTES + mb * 8192;
#pragma unroll
            for (int s = 0; s < 8; ++s) { const bf16x8 kf = *(const LAS bf16x8*)(kb + (ka0 ^ ((unsigned)s << 5))); p = __builtin_amdgcn_mfma_f32_32x32x16_bf16(kf, qf[s], p, 0, 0, 0); }
            if (mb == nb) {
#pragma unroll
                for (int r = 0; r < 16; ++r) if (sb::crow(r, hi) > r32) p[r] = 0.f;
            }
            const u32x4 pa = {cvtpk(p[0], p[1]), cvtpk(p[2], p[3]), cvtpk(p[4], p[5]), cvtpk(p[6], p[7])}, pb = {cvtpk(p[8], p[9]), cvtpk(p[10], p[11]), cvtpk(p[12], p[13]), cvtpk(p[14], p[15])};
            bf16x8 va, vb;
            { s16x4 l0, u0, l1, u1; const unsigned va_ = kvb + vt + (unsigned)mb * 2048u;
              asm volatile("ds_read_b64_tr_b16 %0,%1" : "=&v"(l0) : "v"(va_) : "memory");
              asm volatile("ds_read_b64_tr_b16 %0,%1 offset:512" : "=&v"(u0) : "v"(va_) : "memory");
              asm volatile("ds_read_b64_tr_b16 %0,%1 offset:1024" : "=&v"(l1) : "v"(va_) : "memory");
              asm volatile("ds_read_b64_tr_b16 %0,%1 offset:1536" : "=&v"(u1) : "v"(va_) : "memory");
              asm volatile("s_waitcnt lgkmcnt(0)" : "+v"(l0), "+v"(u0), "+v"(l1), "+v"(u1) :: "memory");
              va = (bf16x8){l0[0], l0[1], l0[2], l0[3], u0[0], u0[1], u0[2], u0[3]}; vb = (bf16x8){l1[0], l1[1], l1[2], l1[3], u1[0], u1[1], u1[2], u1[3]}; }
            o = __builtin_amdgcn_mfma_f32_32x32x16_bf16(__builtin_bit_cast(bf16x8, pa), va, o, 0, 0, 0);
            o = __builtin_amdgcn_mfma_f32_32x32x16_bf16(__builtin_bit_cast(bf16x8, pb), vb, o, 0, 0, 0);
        }
#pragma unroll
        for (int ks = 0; ks < 8; ++ks) { s16x4 lo, up, vl, vu;
            asm volatile("ds_read_b64_tr_b16 %0,%1 offset:%c2" : "=&v"(lo) : "v"(kvb + kt[0]), "i"(ks * 4096) : "memory");
            asm volatile("ds_read_b64_tr_b16 %0,%1 offset:%c2" : "=&v"(up) : "v"(kvb + kt[1]), "i"(ks * 4096) : "memory");
            asm volatile("ds_read_b64_tr_b16 %0,%1 offset:%c2" : "=&v"(vl) : "v"(kvb + vt), "i"(ks * 1024) : "memory");
            asm volatile("ds_read_b64_tr_b16 %0,%1 offset:%c2" : "=&v"(vu) : "v"(kvb + vt), "i"(ks * 1024 + 512) : "memory");
            asm volatile("s_waitcnt lgkmcnt(0)" : "+v"(lo), "+v"(up), "+v"(vl), "+v"(vu) :: "memory");
            const bf16x8 kf = (bf16x8){lo[0], lo[1], lo[2], lo[3], up[0], up[1], up[2], up[3]}, vf = (bf16x8){vl[0], vl[1], vl[2], vl[3], vu[0], vu[1], vu[2], vu[3]};
            st = __builtin_amdgcn_mfma_f32_32x32x16_bf16(kf, vf, st, 0, 0, 0); }
#pragma unroll
        for (int r = 0; r < 16; ++r) st[r] *= g128;
        { LAS unsigned char* sp = lds + ST_OFF + (buf ^ 1) * ST_BYTES + sa;
#pragma unroll
            for (int g = 0; g < 4; ++g) { u32x2 w; w.x = cvtpk(st[4 * g], st[4 * g + 1]); w.y = cvtpk(st[4 * g + 2], st[4 * g + 3]);
                *(LAS u32x2*)(sp + ((((unsigned)(4 * db + g)) ^ sx) << 4) + 8 * hi) = w; } }
        { bf16_t* op = osrc + (long)c * 128 * 2048;
#pragma unroll
            for (int r = 0; r < 16; ++r) op[(long)sb::crow(r, hi) * 2048] = (bf16_t)(cvtpk(o[r], 0.f) & 0xffffu); }
    }
    asm volatile("s_waitcnt vmcnt(0) lgkmcnt(0)\n\ts_barrier" ::: "memory");
#undef RT_DMA
}
}

__device__ __forceinline__ void moe_prepare(Frame& F, int layer, int ncol, bool gather) {
    LAS int* info = (LAS int*)(F.lds + TBL_OFF); LAS int* tok = info + 64;
    const unsigned* gcnt = F.ctl + CW_GCNT + layer * 64; const int* LIST = (const int*)(F.ws + WS_LIST);
    int cnt[NBUCKET]; int RT = 0;
#pragma unroll
    for (int q = 0; q < NBUCKET; ++q) { cnt[q] = (int)__hip_atomic_load(gcnt + q, __ATOMIC_RELAXED, __HIP_MEMORY_SCOPE_AGENT); RT += (cnt[q] + 255) >> 8; }
    for (int i = 0; i < MAXU; ++i) {
        const int L = i * F.G + F.vcu;
        if (L >= RT * ncol) { if (F.tid == 0) info[i * 8] = 0; continue; }
        const int rt = L / ncol, ct = L % ncol; int bucket = 0, ti = 0, cb = 0, accT = 0;
#pragma unroll
        for (int q = 0; q < NBUCKET; ++q) { const int nbk = (cnt[q] + 255) >> 8; if (rt >= accT && rt < accT + nbk) { bucket = q; ti = rt - accT; cb = cnt[q]; } accT += nbk; }
        const int nvalid = (cb - ti * 256) < 256 ? (cb - ti * 256) : 256;
        if (F.tid == 0) { info[i * 8 + 0] = 1; info[i * 8 + 1] = rt; info[i * 8 + 2] = ct; info[i * 8 + 3] = bucket; info[i * 8 + 4] = ti; info[i * 8 + 5] = nvalid; }
        if (gather && F.tid < 256) tok[i * 256 + F.tid] = (F.tid < nvalid) ? LIST[(size_t)bucket * T + ti * 256 + F.tid] : 0;
    }
    __syncthreads();
}
template <bool UP> struct MoeSched {
    static constexpr bool GATHER = UP;
    LAS const int* info; LAS const int* tok; const bf16_t* A; const bf16_t* W; int tid;
    __device__ __forceinline__ bool next(int i, gp::UnitG& u, gp::LaneVA& va) const {
        if (i >= MAXU) return false;
        if (__builtin_amdgcn_readfirstlane(info[i * 8]) == 0) return false;
        const int rt = __builtin_amdgcn_readfirstlane(info[i * 8 + 1]), ct = __builtin_amdgcn_readfirstlane(info[i * 8 + 2]), bucket = __builtin_amdgcn_readfirstlane(info[i * 8 + 3]),
                  ti = __builtin_amdgcn_readfirstlane(info[i * 8 + 4]), nvalid = __builtin_amdgcn_readfirstlane(info[i * 8 + 5]);
        const int g = bucket / 6, pr = bucket % 6; const int la = pr < 3 ? 0 : (pr < 5 ? 1 : 2), lb = pr < 3 ? pr + 1 : (pr < 5 ? pr - 1 : 3);
        u.pm = rt; u.pn = ct; u.x0 = bucket * T + ti * 256; u.x1 = nvalid;
        if constexpr (UP) {
            const int e = 4 * g + ((ct < 4) ? la : lb);
            u.a0 = (const char*)A; u.b0 = (const char*)W + ((size_t)e * 1024 + (size_t)(ct & 3) * 256) * 1024 * 2; u.bjump = 0u; u.bsplit = 1 << 30;
#pragma unroll
            for (int h = 0; h < 2; ++h)
#pragma unroll
                for (int i2 = 0; i2 < 2; ++i2) { int R, C; gp::lane_rc(tid, i2, R, C); va.v[h][i2] = (unsigned)(tok[i * 256 + h * 128 + R] * D + C) * 2u; }
        } else {
            u.a0 = (const char*)A + (size_t)rt * 256 * D * 2; u.b0 = (const char*)W + (((size_t)g * 1024 + (size_t)ct * 256) * 2048 + (size_t)la * 512) * 2; u.bjump = (unsigned)(lb - la - 1) * 1024u; u.bsplit = 8;
        }
        return true;
    }
};

__device__ __forceinline__ void launder(Frame& F) { int w_ = F.wave0; asm volatile("" : "+s"(w_)); int l_ = __builtin_amdgcn_mbcnt_hi(~0u, __builtin_amdgcn_mbcnt_lo(~0u, 0u)); asm volatile("" : "+v"(l_)); F.lane = l_; F.wave = w_; F.tid = w_ * 64 + l_;
    F.out = (float*)kin(17); F.ws = (unsigned char*)kin(18); F.ctl = (unsigned*)(F.ws + WS_CTL);
    int g_ = gridDim.x, bx_ = blockIdx.x; asm volatile("" : "+s"(g_), "+s"(bx_)); F.G = g_; F.bx = bx_; F.vcu = (g_ % 8 == 0) ? (bx_ % 8) * (g_ / 8) + bx_ / 8 : bx_; }
#ifndef MK_PER_PHASE
#define MK_PER_PHASE 0
#endif
constexpr int N_PHASES = 2 + 8 * DEPTH;
struct Args { const void* in[17]; float* out; unsigned char* ws; int ph_lo, ph_hi; };
__global__ void __launch_bounds__(512, 2) fwd(Args args) {
    extern __shared__ __attribute__((aligned(16))) unsigned char lds_raw[];
    Frame F;
    F.lds = (LAS unsigned char*)lds_raw; F.ws = args.ws; F.ctl = (unsigned*)(args.ws + WS_CTL);
    F.tid = threadIdx.x; F.lane = F.tid & 63; F.wave = __builtin_amdgcn_readfirstlane(F.tid >> 6); F.wave0 = F.wave;
    F.G = gridDim.x; { const int bx = blockIdx.x; F.bx = bx; F.vcu = (F.G % 8 == 0) ? (bx % 8) * (F.G / 8) + bx / 8 : bx; }
    F.out = args.out;
    for (int u = F.tid; u < (LDS_BYTES - LDSCTL_OFF) / 4; u += 512) ((LAS unsigned*)(F.lds + LDSCTL_OFF))[u] = 0u;
    __syncthreads();
    XcdBarrier bar; bar.bar = F.ctl + CW_BAR; bar.x = 0; bar.st = nullptr;
    if (!MK_PER_PHASE) bar = xcd_barrier_post(F.ctl + CW_BAR, (volatile LAS unsigned*)(F.lds + LDSCTL_OFF + 32));
    const int lo = args.ph_lo, hi = args.ph_hi;
#ifndef PH_MASK
#define PH_MASK 0xFFFF
#endif
#define IN(k) (lo <= (k) && (k) < hi)
#define PM(bit) (launder(F), (PH_MASK >> (bit)) & 1)
#define GRID_BAR() do { if (!MK_PER_PHASE) { XcdBarrier b2_ = bar; asm volatile("" : "+s"(b2_.bar)); xcd_barrier(b2_); } } while (0)
#define PJ (F.ws + WS_PROJ)
#define XN ((bf16_t*)(F.ws + WS_XN))

    if (PM(0) && IN(0)) { p0_prologue(F); GRID_BAR(); }
    if (PM(1) && IN(1)) { p1_mod0(F); GRID_BAR(); }
    for (int L = 0; L < DEPTH; ++L) {
        const int pb = 2 + 8 * L, ml = L >> 1;
        const bf16_t* Ymix;
        if ((L & 1) == 0) {
            bf16_t* Q = (bf16_t*)(PJ + PJ_Q); Ymix = (const bf16_t*)(PJ + PJ_K);
            if (PM(2) && IN(pb + 0)) {
                gp::PlainSched S; S.A = XN; S.Bt = (const bf16_t*)(F.ws + WS_WQKV) + (size_t)ml * 3072 * 1024; S.lda = D; S.ldb = D; S.tid = F.tid; S.so.init(T, 3072, F.G, F.bx);
                gp::EpiQKV E{Q, SB_QSCALE};
                gp::gemm_phase<gp::EpiQKV, gp::PlainSched>(F.lds, F.tid, D, D, D, S, E);
                GRID_BAR();
            }
            if (PM(3) && IN(pb + 1)) {
                const int NU = BATCH * 16 * (SEQ / 256);
                for (int uu = F.vcu; uu < NU; uu += F.G) { const int bh = uu >> 4, qb = uu & 15; sb::unit(F.tid, bh >> 4, bh & 15, qb, Q, Q + (size_t)T * D, Q + (size_t)2 * T * D, Q, F.lds); }
                moe_weight_phase(F, L);
                GRID_BAR();
            }
        } else {
            bf16_t* RQ = (bf16_t*)(PJ + PJ_RQ); bf16_t* RK = (bf16_t*)(PJ + PJ_RK); bf16_t* RV = (bf16_t*)(PJ + PJ_RV); bf16_t* RG = (bf16_t*)(PJ + PJ_RG); Ymix = (const bf16_t*)(PJ + PJ_RQ);
            if (PM(4) && IN(pb + 0)) {
                gp::PlainSched S; S.A = XN; S.Bt = (const bf16_t*)(F.ws + WS_WRI) + (size_t)ml * 6144 * 1024; S.lda = D; S.ldb = D; S.tid = F.tid; S.so.init(T, 6144, F.G, F.bx);
                gp::EpiRet E{RQ, RK, RV, RG, (const f32x2*)(F.ws + WS_CS)};
                gp::gemm_phase<gp::EpiRet, gp::PlainSched>(F.lds, F.tid, D, D, D, S, E);
                GRID_BAR();
            }
            if (PM(5) && IN(pb + 1)) {
                for (int uu = F.vcu; uu < BATCH * 8 * 4; uu += F.G) { const int bh = uu >> 2; ret::unit(F.tid, bh >> 3, bh & 7, uu & 3, RQ, RK, RV, F.lds); }
                moe_weight_phase(F, L);
                GRID_BAR();
            }
            if (PM(6) && IN(pb + 2)) { gate_phase(F, ml); GRID_BAR(); }
        }
        if (PM(7) && IN(pb + 3)) {
            const bool sbl = (L & 1) == 0;
            gp::PlainSched S; S.A = sbl ? (const bf16_t*)(PJ + PJ_Q) : (const bf16_t*)(PJ + PJ_RV);
            S.Bt = sbl ? (const bf16_t*)(F.ws + WS_WSO) + (size_t)ml * 1024 * 1024 : (const bf16_t*)(F.ws + WS_WRO) + (size_t)ml * 1024 * 2048;
            const int K = sbl ? 1024 : 2048; S.lda = K; S.ldb = K; S.tid = F.tid; S.so.init(T, D, F.G, F.bx);
            gp::EpiY E{(bf16_t*)Ymix};
            gp::gemm_phase<gp::EpiY, gp::PlainSched>(F.lds, F.tid, K, K, K, S, E);
            GRID_BAR();
        }
        if (PM(8) && IN(pb + 4)) { ln_phase(F, L == 0 ? ((const float*)kin(0)) : (const float*)F.out, Ymix, 2 * L, 2 * L + 1, true, L); GRID_BAR(); }
        if (PM(9) && IN(pb + 5)) {
            moe_prepare(F, L, 8, true);
            MoeSched<true> S{(LAS const int*)(F.lds + TBL_OFF), (LAS const int*)(F.lds + TBL_OFF) + 64, XN, (const bf16_t*)(F.ws + WS_WGU), F.tid};
            gp::EpiUp E{(bf16_t*)(PJ + PJ_HID), (const f32x2*)(F.ws + WS_WTS)};
            gp::gemm_phase<gp::EpiUp, MoeSched<true>>(F.lds, F.tid, D, D, D, S, E);
            GRID_BAR();
        }
        if (PM(10) && IN(pb + 6)) {
            moe_prepare(F, L, 4, false);
            MoeSched<false> S{(LAS const int*)(F.lds + TBL_OFF), (LAS const int*)(F.lds + TBL_OFF) + 64, (const bf16_t*)(PJ + PJ_HID), (const bf16_t*)(F.ws + WS_WD), F.tid};
            gp::EpiDown E{(bf16_t*)(PJ + PJ_Y2), (const int*)(F.ws + WS_LIST)};
            gp::gemm_phase<gp::EpiDown, MoeSched<false>>(F.lds, F.tid, D, D, 2048, S, E);
            GRID_BAR();
        }
        if (PM(11) && IN(pb + 7)) { ln_phase(F, (const float*)F.out, (const bf16_t*)(PJ + PJ_Y2), 2 * L + 1, (L + 1 < DEPTH) ? 2 * L + 2 : -1, false, L); if (L + 1 < DEPTH) GRID_BAR(); }
    }
#undef IN
#undef GRID_BAR
}

__global__ void dbg_dump(const bf16_t* src, float* out) { for (size_t i = blockIdx.x * 256 + threadIdx.x; i < (size_t)T * D; i += 1024 * 256) out[i] = bf2f(src[i]); }
extern "C" void kernel_launch(void* const* d_in, const int* in_sizes, int n_in, void* d_out, int out_size, void* d_ws, size_t ws_size, hipStream_t stream) {
    static int grid = 0;
    if (grid == 0) {
        if (n_in != 17 || in_sizes[0] != T * D || out_size != T * D || ws_size < WS_END) { fprintf(stderr, "kernel_launch: unexpected shapes / workspace (%d inputs, ws %zu)\n", n_in, ws_size); grid = -1; return; }
        int dev = 0, cus = 0, per_cu = 0;
        if (hipGetDevice(&dev) != hipSuccess || hipDeviceGetAttribute(&cus, hipDeviceAttributeMultiprocessorCount, dev) != hipSuccess) { grid = -1; return; }
        if (hipFuncSetAttribute((const void*)fwd, hipFuncAttributeMaxDynamicSharedMemorySize, LDS_BYTES) != hipSuccess) { fprintf(stderr, "kernel_launch: hipFuncSetAttribute failed\n"); grid = -1; return; }
        if (hipOccupancyMaxActiveBlocksPerMultiprocessor(&per_cu, (const void*)fwd, 512, LDS_BYTES) != hipSuccess || per_cu < 1) { fprintf(stderr, "kernel_launch: occupancy query reports %d\n", per_cu); }
        (void)hipGetLastError();
        grid = cus;
        if (grid > 256) grid = 256;
        while (grid > 8 && ((T % grid) != 0 || (SEQ % (T / grid)) != 0 || (grid % 8) != 0)) --grid;
    }
    if (grid < 0) return;
    (void)hipMemsetAsync((char*)d_ws, 0, ZERO_BYTES, stream);
    Args a{};
    for (int i = 0; i < 17; ++i) a.in[i] = d_in[i];
    a.out = (float*)d_out; a.ws = (unsigned char*)d_ws;
#if MK_PER_PHASE
#ifndef DBG_STOP
#define DBG_STOP N_PHASES
#endif
#ifndef DBG_OFF
#define DBG_OFF (-1)
#endif
    for (int p = 0; p < DBG_STOP; ++p) { a.ph_lo = p; a.ph_hi = p + 1; hipLaunchKernelGGL(fwd, dim3(grid), dim3(512), LDS_BYTES, stream, a); }
    if (DBG_OFF >= 0) hipLaunchKernelGGL(dbg_dump, dim3(1024), dim3(256), 0, stream, (const bf16_t*)((const unsigned char*)d_ws + (size_t)DBG_OFF * MiB), (float*)d_out);
#else
    a.ph_lo = 0; a.ph_hi = N_PHASES;
    hipLaunchKernelGGL(fwd, dim3(grid), dim3(512), LDS_BYTES, stream, a);
#endif
}
```

```cpp
#include <hip/hip_runtime.h>
#include <cstdio>
#include <cstdint>
#include <cmath>

#define LAS __attribute__((address_space(3)))
#define GAS __attribute__((address_space(1)))
typedef unsigned short bf16_t;
typedef short bf16x8 __attribute__((ext_vector_type(8)));
typedef short s16x4 __attribute__((ext_vector_type(4)));
typedef float f32x4 __attribute__((ext_vector_type(4)));
typedef float f32x2 __attribute__((ext_vector_type(2)));
typedef float f32x16 __attribute__((ext_vector_type(16)));
typedef unsigned u32x4 __attribute__((ext_vector_type(4)));
typedef unsigned u32x2 __attribute__((ext_vector_type(2)));
typedef __bf16 bf16x2_t __attribute__((ext_vector_type(2)));
typedef int v8i __attribute__((ext_vector_type(8)));

constexpr int BATCH = 8, SEQ = 4096, D = 1024, T = BATCH * SEQ, DEPTH = 4;
constexpr int NBUCKET = 24;
constexpr float LN_EPS = 1e-5f;
constexpr float DN_ALPHA = 1.6817928305074292f;
constexpr float LOG2E = 1.4426950408889634f;
constexpr float SB_QSCALE = 0.125f * LOG2E;
constexpr float SB_EXIT = -152.0f;

__device__ __forceinline__ unsigned cvtpk(float lo, float hi) { f32x2 v = {lo, hi}; bf16x2_t b = __builtin_convertvector(v, bf16x2_t); return __builtin_bit_cast(unsigned, b); }
__device__ __forceinline__ float bf2f(unsigned short h) { return __builtin_bit_cast(float, (unsigned)h << 16); }
__device__ __forceinline__ float bflo(unsigned w) { return __builtin_bit_cast(float, w << 16); }
__device__ __forceinline__ float bfhi(unsigned w) { return __builtin_bit_cast(float, w & 0xffff0000u); }
__device__ __forceinline__ unsigned pk4_fp8(float a, float b, float c, float d) { int w = 0; w = __builtin_amdgcn_cvt_pk_fp8_f32(a, b, w, false); w = __builtin_amdgcn_cvt_pk_fp8_f32(c, d, w, true); return (unsigned)w; }
#define LDS_WAIT() asm volatile("s_waitcnt lgkmcnt(0)" ::: "memory")
#define VM_WAIT() asm volatile("s_waitcnt vmcnt(0)" ::: "memory")
#define SBAR() __builtin_amdgcn_sched_barrier(0)

#ifndef PROBE_CLASS
#define PROBE_CLASS 0
#endif
#ifndef PROBE_GSITE
#define PROBE_GSITE 0
#endif
namespace gp {
constexpr int BM = 256, BK = 64, HALF = 128, HTB = HALF * BK * 2, STAGE_BYTES = 8 * HTB, NXCD = 8, WGM = 8;
__host__ __device__ __forceinline__ int lds_byte(int r, int c) { const int st = (r >> 4) * 2 + (c >> 5), rr = r & 15, cc = c & 31, ob = rr * 64 + cc * 2; return st * 1024 + (ob ^ (((ob >> 9) & 1) << 5)); }
__host__ __device__ __forceinline__ void stage_rc(int b, int& R, int& C) { const int st = b / 1024, sb = b % 1024, swz = sb ^ (((sb >> 9) & 1) << 5); R = (st >> 1) * 16 + swz / 64; C = (st & 1) * 32 + (swz % 64) / 2; }
__host__ __device__ __forceinline__ int perm32(int rho) { const int n = rho >> 4, i = rho & 15; return 8 * (i >> 2) + 4 * n + (i & 3); }

__device__ __forceinline__ void lane_rc(int tid, int i, int& R, int& C) { stage_rc(tid * 16 + i * 8192, R, C); }
struct UnitG { int pm, pn; const char* a0; const char* b0; unsigned bjump; int bsplit; int x0, x1; int tb; };
struct LaneVA { unsigned v[2][2]; };

struct StaticOrder {
    int nM, nN, nwg, G, c;
    __device__ void init(int M, int N, int G_, int c_) { nM = M / BM; nN = N / BM; nwg = nM * nN; G = G_; c = c_; }
    __device__ bool next(int i, int& pm, int& pn) const {
        const long L = (long)i * G + c; if (L >= nwg) return false;
        int wgid = (int)L; { const int q = nwg / NXCD, r = nwg % NXCD, xcd = wgid % NXCD, off = wgid / NXCD; wgid = (xcd < r ? xcd * (q + 1) : r * (q + 1) + (xcd - r) * q) + off; }
        const int nig = WGM * nN, gid = wgid / nig, fm = gid * WGM, gsz = (nM - fm) < WGM ? (nM - fm) : WGM;
        pm = fm + ((wgid % nig) % gsz); pn = (wgid % nig) / gsz; return true;
    }
};
template <bool F8> struct PlainSchedT {
    static constexpr bool GATHER = false, FP8 = F8, SKEW = false;
    const bf16_t* A; const bf16_t* Bt; int lda, ldb, tid; StaticOrder so; int pn_off = 0;
    __device__ __forceinline__ bool next(int i, UnitG& u, LaneVA&) const {
        int pm, pn; if (!so.next(i, pm, pn)) return false;
        u.pm = pm; u.pn = pn + pn_off; u.a0 = (const char*)A + (size_t)pm * BM * lda * 2; u.b0 = (const char*)Bt + (size_t)pn * BM * ldb * 2; u.bjump = 0u; u.bsplit = 1 << 30; u.x0 = 0; u.x1 = 0; u.tb = 0;
        return true;
    }
};
typedef PlainSchedT<false> PlainSched;
struct SkewSched {
    static constexpr bool GATHER = false, FP8 = false, SKEW = true;
    PlainSched P;
    __device__ __forceinline__ int skew() const { return (P.so.nwg % P.so.G == 0 && P.so.G == 256) ? ((P.so.c >> 4) & 3) : 0; }
    __device__ __forceinline__ bool next(int i, UnitG& u, LaneVA& va) const {
        if (P.next(i, u, va)) return true;
        const int s = skew();
        if (s == 0 || i == 0 || (long)(i - 1) * P.so.G + P.so.c >= P.so.nwg) return false;
        P.next(0, u, va); const size_t ko = (size_t)((P.lda / BK) >> 2) * s * (BK * 2); u.a0 += ko; u.b0 += ko; return true;
    }
};
__device__ __forceinline__ unsigned char* skew_scratch();

template <class Epi, class Sched>
__device__ __forceinline__ void gemm_phase(LAS unsigned char* lds, const int tid, const int K, const int lda, const int ldb, const Sched& S, const Epi& E, unsigned long long& tsel, const int gsite) {
    const int wid = __builtin_amdgcn_readfirstlane(tid >> 6), lane = tid & 63, wr = wid >> 2, wc = wid & 3, fr = lane & 15, fq = lane >> 4;
    const int nt = K / BK;
    constexpr bool GA = Sched::GATHER;
    constexpr bool SK = Sched::SKEW;
    constexpr bool F8 = Sched::FP8;
    unsigned voffA, voffB;
    { int R, C; stage_rc(tid * 16, R, C); const int Rb = (R & ~31) + perm32(R & 31); voffA = GA ? ((unsigned)(R * 4) | ((unsigned)(C * 2) << 16)) : (unsigned)(R * lda + C) * 2u; voffB = (unsigned)(Rb * ldb + C) * 2u; }
    const size_t kstep = (size_t)(BK * 2);
    const size_t hstepB = (size_t)HALF * ldb * 2, pstepB = (size_t)64 * ldb * 2;
    const size_t hstepA = (size_t)HALF * lda * 2, pstepA = (size_t)64 * lda * 2;
    const unsigned ldsw = (unsigned)wid * 1024u;
    const int aoff = lds_byte(wr * 64 + fr, fq * 8), boff = lds_byte(wc * 32 + fr, fq * 8);
    const int sub8 = (fq >> 1) * 1024 + ((fr * 64 + 32 * (fq & 1)) ^ (((fr >> 3) & 1) << 5));
    const int aoff8 = wr * 8 * 1024 + sub8, boff8 = wc * 4 * 1024 + sub8;
    int sc8 = 0x7f7f7f7f; asm volatile("" : "+v"(sc8));
#define PG8_SA(b, h) (((b) * 2 + (h)) * HTB)
#define PG8_SB(b, h) ((4 + (b) * 2 + (h)) * HTB)
#define PG8_LD1(bufoff, gptr) __builtin_amdgcn_global_load_lds((const unsigned*)(gptr), (LAS unsigned*)(lds + (bufoff) + ldsw), 16, 0, 0)
#define PG8_STAGE_B(bufoff, gbase) do { PG8_LD1(bufoff, (const char*)(gbase) + voffB); PG8_LD1((bufoff) + 8192, (const char*)(gbase) + pstepB + voffB); } while (0)
#define PG8_GTB(tb, h) do { if constexpr (GA) { const unsigned ta_ = ldsa + (unsigned)(tb) + (h) * 512 + (voffA & 0xffffu); asm volatile("ds_read2st64_b32 %0, %1 offset1:1" : "=v"(gpair) : "v"(ta_) : "memory"); } } while (0)
#define PG8_STAGE_A(bufoff, gbase, h, VA) do { if constexpr (GA) { asm volatile("s_waitcnt lgkmcnt(0)" : "+v"(gpair) :: "memory"); PG8_LD1(bufoff, (const char*)(gbase) + (gpair.x + (voffA >> 16))); PG8_LD1((bufoff) + 8192, (const char*)(gbase) + (gpair.y + (voffA >> 16))); } \
        else { PG8_LD1(bufoff, (const char*)(gbase) + (h) * hstepA + voffA); PG8_LD1((bufoff) + 8192, (const char*)(gbase) + (h) * hstepA + pstepA + voffA); } } while (0)
#define PG8_LDA(dst, b, h) do { _Pragma("unroll") for (int m = 0; m < 4; ++m) _Pragma("unroll") for (int k = 0; k < 2; ++k) dst[m][k] = *(const LAS bf16x8*)(lds + PG8_SA(b, h) + aoff + m * 2048 + k * 1024); } while (0)
#define PG8_LDB(dst, b, h) do { _Pragma("unroll") for (int n = 0; n < 2; ++n) _Pragma("unroll") for (int k = 0; k < 2; ++k) dst[n][k] = *(const LAS bf16x8*)(lds + PG8_SB(b, h) + boff + n * 2048 + k * 1024); } while (0)
#define PG8_MMA(ai, bj, At, Bt) do { __builtin_amdgcn_s_setprio(1); _Pragma("unroll") for (int m = 0; m < 4; ++m) _Pragma("unroll") for (int n = 0; n < 2; ++n) _Pragma("unroll") for (int k = 0; k < 2; ++k) \
        acc[ai][bj][m][n] = __builtin_amdgcn_mfma_f32_16x16x32_bf16(Bt[n][k], At[m][k], acc[ai][bj][m][n], 0, 0, 0); __builtin_amdgcn_s_setprio(0); } while (0)
#define PG8_LDA8(dst, b, h) do { _Pragma("unroll") for (int m = 0; m < 4; ++m) { const u32x4 x0_ = *(const LAS u32x4*)(lds + PG8_SA(b, h) + aoff8 + m * 2048), x1_ = *(const LAS u32x4*)(lds + PG8_SA(b, h) + aoff8 + m * 2048 + 16); \
        dst[m] = __builtin_bit_cast(v8i, __builtin_shufflevector(x0_, x1_, 0, 1, 2, 3, 4, 5, 6, 7)); } } while (0)
#define PG8_LDB8(dst, b, h) do { _Pragma("unroll") for (int n = 0; n < 2; ++n) { const u32x4 x0_ = *(const LAS u32x4*)(lds + PG8_SB(b, h) + boff8 + n * 2048), x1_ = *(const LAS u32x4*)(lds + PG8_SB(b, h) + boff8 + n * 2048 + 16); \
        dst[n] = __builtin_bit_cast(v8i, __builtin_shufflevector(x0_, x1_, 0, 1, 2, 3, 4, 5, 6, 7)); } } while (0)
#define PG8_MMA8(ai, bj, A8, B8) do { __builtin_amdgcn_s_setprio(1); _Pragma("unroll") for (int m = 0; m < 4; ++m) _Pragma("unroll") for (int n = 0; n < 2; ++n) \
        acc[ai][bj][m][n] = __builtin_amdgcn_mfma_scale_f32_16x16x128_f8f6f4(B8[n], A8[m], acc[ai][bj][m][n], 0, 0, 0, sc8, 0, sc8); __builtin_amdgcn_s_setprio(0); } while (0)
#define PG8_RDB(B0x, B1x, B08x, B18x, b) do { if constexpr (F8) { PG8_LDB8(B08x, b, 0); PG8_LDB8(B18x, b, 1); } else { PG8_LDB(B0x, b, 0); PG8_LDB(B1x, b, 1); } } while (0)
#define PG8_RDA(b, h) do { if constexpr (F8) { PG8_LDA8(At8, b, h); } else { PG8_LDA(At, b, h); } } while (0)
#define PG8_PIN(ai) asm volatile("" : "+v"(acc[ai][0][0][0]), "+v"(acc[ai][0][0][1]), "+v"(acc[ai][0][1][0]), "+v"(acc[ai][0][1][1]), "+v"(acc[ai][0][2][0]), "+v"(acc[ai][0][2][1]), "+v"(acc[ai][0][3][0]), "+v"(acc[ai][0][3][1]), \
        "+v"(acc[ai][1][0][0]), "+v"(acc[ai][1][0][1]), "+v"(acc[ai][1][1][0]), "+v"(acc[ai][1][1][1]), "+v"(acc[ai][1][2][0]), "+v"(acc[ai][1][2][1]), "+v"(acc[ai][1][3][0]), "+v"(acc[ai][1][3][1]))
#define PG8_MM(ai) do { if constexpr (F8) { PG8_MMA8(ai, 0, At8, B08); PG8_MMA8(ai, 1, At8, B18); PG8_PIN(ai); } else { PG8_MMA(ai, 0, At, B0); PG8_MMA(ai, 1, At, B1); } } while (0)
#define PG8_F8SB do { if constexpr (F8) SBAR(); } while (0)
#define PG8_WAIT_V(n) asm volatile("s_waitcnt vmcnt(" #n ")" ::: "memory")
#define PG8_WAIT_L(n) asm volatile("s_waitcnt lgkmcnt(" #n ")" ::: "memory")
#define PG8_BAR __builtin_amdgcn_s_barrier()
#define PG8_BPTR(u, kt) ((u).b0 + (size_t)(kt) * kstep + (((kt) >= (u).bsplit) ? (size_t)(u).bjump : (size_t)0))
    UnitG cur, nxt; LaneVA cva, nva; int ui = 0; unsigned tpe = 0u; u32x2 gpair = {0u, 0u}; const unsigned ldsa = (unsigned)(size_t)lds;
    if (!S.next(0, cur, cva)) return;
    f32x4 acc[2][2][4][2];
#pragma unroll
    for (int a = 0; a < 2; ++a)
#pragma unroll
        for (int b = 0; b < 2; ++b)
#pragma unroll
            for (int m = 0; m < 4; ++m)
#pragma unroll
                for (int n = 0; n < 2; ++n) acc[a][b][m][n] = (f32x4){0.f, 0.f, 0.f, 0.f};
    bf16x8 At[4][2], B0[2][2], B1[2][2]; v8i At8[4], B08[2], B18[2];
    {
        const char* cA = cur.a0; const char* cB = cur.b0;
        PG8_STAGE_B(PG8_SB(0, 0), cB); PG8_STAGE_B(PG8_SB(0, 1), cB + hstepB); PG8_GTB(cur.tb, 0); PG8_STAGE_A(PG8_SA(0, 0), cA, 0, cva); PG8_GTB(cur.tb, 1); PG8_STAGE_A(PG8_SA(0, 1), cA, 1, cva);
        if (wr == 1) PG8_BAR;
        PG8_WAIT_V(2); PG8_BAR;
        PG8_STAGE_B(PG8_SB(1, 0), cB + kstep); PG8_GTB(cur.tb, 0); PG8_STAGE_A(PG8_SA(1, 0), cA + kstep, 0, cva); PG8_STAGE_B(PG8_SB(1, 1), cB + hstepB + kstep);
        PG8_WAIT_V(6); PG8_BAR;
    }
    for (;;) {
        const bool has_next = S.next(ui + 1, nxt, nva);
        if (!has_next) nxt = cur;
        const char* nA = nxt.a0; const char* nB = nxt.b0;
        const unsigned tk0_ = (PROBE_CLASS == 44 || PROBE_CLASS == 45) ? (PROBE_CLASS == 44 ? (unsigned)__builtin_amdgcn_s_memtime() : (unsigned)__builtin_amdgcn_s_memrealtime()) : 0u;
        int nk = nt, pmode = 0;
        if constexpr (SK) { const int sk = S.skew(); if (sk) { if (ui == 0) { nk = (nt >> 2) * sk; pmode = 1; } else if (!has_next) { nk = nt - (nt >> 2) * sk; pmode = 2; } } }
        if constexpr (SK) {
            if (pmode == 2) { int l_ = lane; asm volatile("" : "+v"(l_)); const f32x4* Pp = (const f32x4*)skew_scratch() + (size_t)wid * 2048 + l_;
#pragma unroll
                for (int a = 0; a < 2; ++a)
#pragma unroll
                    for (int b = 0; b < 2; ++b)
#pragma unroll
                        for (int m = 0; m < 4; ++m)
#pragma unroll
                            for (int n = 0; n < 2; ++n) acc[a][b][m][n] = Pp[(((a * 2 + b) * 4 + m) * 2 + n) * 64];
            }
        }
        for (int t = 0; t < nk; t += 2) {
            const bool last = (t == nk - 2);
            const char* a1 = cur.a0 + (size_t)(t + 1) * kstep;
            const char* a2 = last ? nA : cur.a0 + (size_t)(t + 2) * kstep; const char* b2 = last ? nB : PG8_BPTR(cur, t + 2);
            const char* a3 = a2 + kstep; const char* b3 = b2 + kstep;
            const int tb2 = last ? nxt.tb : cur.tb;
            PG8_GTB(cur.tb, 1); PG8_RDB(B0, B1, B08, B18, 0); SBAR(); PG8_RDA(0, 0); PG8_STAGE_A(PG8_SA(1, 1), a1, 1, cva);
            PG8_WAIT_V(8); PG8_WAIT_L(0); PG8_BAR; if (PROBE_CLASS == 43 && gsite == PROBE_GSITE && t == 0 && ui > 0) tsel += (unsigned)__builtin_amdgcn_s_memrealtime() - tpe; PG8_F8SB; PG8_MM(0); PG8_F8SB; PG8_BAR; SBAR();
            PG8_GTB(tb2, 0); PG8_RDA(0, 1); PG8_STAGE_B(PG8_SB(0, 0), b2); PG8_STAGE_B(PG8_SB(0, 1), b2 + hstepB); PG8_STAGE_A(PG8_SA(0, 0), a2, 0, cva);
            PG8_WAIT_V(8); PG8_WAIT_L(0); PG8_BAR; PG8_F8SB; PG8_MM(1); PG8_F8SB; PG8_BAR; SBAR();
            PG8_GTB(tb2, 1); PG8_RDB(B0, B1, B08, B18, 1); SBAR(); PG8_RDA(1, 0); PG8_STAGE_A(PG8_SA(0, 1), a2, 1, cva);
            PG8_WAIT_V(8); PG8_WAIT_L(0); PG8_BAR; PG8_F8SB; PG8_MM(0); PG8_F8SB; PG8_BAR; SBAR();
            PG8_GTB(tb2, 0); PG8_RDA(1, 1); PG8_STAGE_B(PG8_SB(1, 0), b3); PG8_STAGE_B(PG8_SB(1, 1), b3 + hstepB); PG8_STAGE_A(PG8_SA(1, 0), a3, 0, cva);
            PG8_WAIT_V(8); PG8_WAIT_L(0); PG8_BAR; PG8_F8SB; PG8_MM(1); PG8_F8SB; PG8_BAR; SBAR();
        }
        if ((PROBE_CLASS == 44 || PROBE_CLASS == 45) && gsite == PROBE_GSITE) tsel += (PROBE_CLASS == 44 ? (unsigned)__builtin_amdgcn_s_memtime() : (unsigned)__builtin_amdgcn_s_memrealtime()) - tk0_;
        if (wr == 0) PG8_BAR;
#pragma unroll
        for (int a = 0; a < 2; ++a)
#pragma unroll
            for (int b = 0; b < 2; ++b) asm volatile("" : "+v"(acc[a][b][0][0]), "+v"(acc[a][b][0][1]), "+v"(acc[a][b][1][0]), "+v"(acc[a][b][1][1]), "+v"(acc[a][b][2][0]), "+v"(acc[a][b][2][1]), "+v"(acc[a][b][3][0]), "+v"(acc[a][b][3][1]));
        if (PROBE_CLASS == 43 && gsite == PROBE_GSITE) tpe = (unsigned)__builtin_amdgcn_s_memrealtime();
        if constexpr (SK) {
            if (pmode == 1) { int l_ = lane; asm volatile("" : "+v"(l_)); f32x4* Pp = (f32x4*)skew_scratch() + (size_t)wid * 2048 + l_;
#pragma unroll
                for (int a = 0; a < 2; ++a)
#pragma unroll
                    for (int b = 0; b < 2; ++b)
#pragma unroll
                        for (int m = 0; m < 4; ++m)
#pragma unroll
                            for (int n = 0; n < 2; ++n) Pp[(((a * 2 + b) * 4 + m) * 2 + n) * 64] = acc[a][b][m][n];
            } else {
                E(acc, cur, wr, wc, fr, fq);
            }
        } else
        if (PROBE_CLASS == 40 && gsite == PROBE_GSITE) { const unsigned t0_ = (unsigned)__builtin_amdgcn_s_memrealtime(); E(acc, cur, wr, wc, fr, fq); asm volatile("s_waitcnt vmcnt(0)" ::: "memory"); tsel += (unsigned)__builtin_amdgcn_s_memrealtime() - t0_; } else
        E(acc, cur, wr, wc, fr, fq);
        if (PROBE_CLASS == 43 && gsite == PROBE_GSITE && !has_next) tsel += (unsigned)__builtin_amdgcn_s_memrealtime() - tpe;
        if (!has_next) break;
#pragma unroll
        for (int a = 0; a < 2; ++a)
#pragma unroll
            for (int b = 0; b < 2; ++b)
#pragma unroll
                for (int m = 0; m < 4; ++m)
#pragma unroll
                    for (int n = 0; n < 2; ++n) acc[a][b][m][n] = (f32x4){0.f, 0.f, 0.f, 0.f};
        cur = nxt; ++ui;
        if (wr == 1) PG8_BAR;
    }
    PG8_WAIT_V(0);
    PG8_BAR;
#undef PG8_SA
#undef PG8_SB
#undef PG8_LD1
#undef PG8_STAGE_A
#undef PG8_GTB
#undef PG8_STAGE_B
#undef PG8_LDA
#undef PG8_LDB
#undef PG8_MMA
#undef PG8_LDA8
#undef PG8_LDB8
#undef PG8_MMA8
#undef PG8_RDB
#undef PG8_RDA
#undef PG8_MM
#undef PG8_PIN
#undef PG8_F8SB
#undef PG8_WAIT_V
#undef PG8_WAIT_L
#undef PG8_BAR
#undef PG8_BPTR
}

__device__ __forceinline__ u32x4 pack8(const f32x4& v0, const f32x4& v1, float s) {
    u32x4 w; w.x = cvtpk(v0[0] * s, v0[1] * s); w.y = cvtpk(v0[2] * s, v0[3] * s); w.z = cvtpk(v1[0] * s, v1[1] * s); w.w = cvtpk(v1[2] * s, v1[3] * s); return w;
}
struct EpiQKV {
    bf16_t* Q; float qscale;
    __device__ __forceinline__ void operator()(const f32x4 (&acc)[2][2][4][2], const UnitG& u, int wr, int wc, int fr, int fq) const {
        const int t = u.pn >> 2; bf16_t* base = Q + (size_t)t * T * D; const float sc = (t == 0) ? qscale : 1.f;
        const int col0 = (u.pn & 3) * BM + wc * 32 + 8 * fq, row0 = u.pm * BM + wr * 64 + fr;
#pragma unroll
        for (int ai = 0; ai < 2; ++ai)
#pragma unroll
            for (int m = 0; m < 4; ++m) { bf16_t* rowp = base + (size_t)(row0 + ai * HALF + m * 16) * D + col0;
#pragma unroll
                for (int bj = 0; bj < 2; ++bj) *(u32x4*)(rowp + bj * HALF) = pack8(acc[ai][bj][m][0], acc[ai][bj][m][1], sc); }
    }
};
struct EpiY {
    bf16_t* Y; float ysc;
    __device__ __forceinline__ void operator()(const f32x4 (&acc)[2][2][4][2], const UnitG& u, int wr, int wc, int fr, int fq) const {
        const int col0 = u.pn * BM + wc * 32 + 8 * fq, row0 = u.pm * BM + wr * 64 + fr;
#pragma unroll
        for (int ai = 0; ai < 2; ++ai)
#pragma unroll
            for (int m = 0; m < 4; ++m) { bf16_t* rowp = Y + (size_t)(row0 + ai * HALF + m * 16) * D + col0;
#pragma unroll
                for (int bj = 0; bj < 2; ++bj) *(u32x4*)(rowp + bj * HALF) = pack8(acc[ai][bj][m][0], acc[ai][bj][m][1], ysc); }
    }
};
struct EpiRet {
    bf16_t *RQ, *RK, *RV, *RG; const f32x2* CS;
    __device__ __forceinline__ void operator()(const f32x4 (&acc)[2][2][4][2], const UnitG& u, int wr, int wc, int fr, int fq) const {
        const int row0 = u.pm * BM + wr * 64 + fr;
        if (u.pn >= 8) {
            bf16_t* base = (u.pn >= 16) ? RG : RV; const int col0 = (u.pn & 7) * BM + wc * 32 + 8 * fq;
#pragma unroll
            for (int ai = 0; ai < 2; ++ai)
#pragma unroll
                for (int m = 0; m < 4; ++m) { bf16_t* rowp = base + (size_t)(row0 + ai * HALF + m * 16) * 2048 + col0;
#pragma unroll
                    for (int bj = 0; bj < 2; ++bj) *(u32x4*)(rowp + bj * HALF) = pack8(acc[ai][bj][m][0], acc[ai][bj][m][1], 1.f); }
        } else {
            const bool isk = u.pn >= 4; const int head = 2 * (u.pn & 3) + (wc >> 1), jb = (wc & 1) * 32 + 8 * fq;
            const float lg = __builtin_log2f(1.0f - __builtin_exp2f(-5.0f - (float)head));
            bf16_t* base = (isk ? RK : RQ) + head * 128 + jb;
#pragma unroll
            for (int ai = 0; ai < 2; ++ai)
#pragma unroll
                for (int m = 0; m < 4; ++m) {
                    const int row = row0 + ai * HALF + m * 16; const float np1 = (float)((row & 127) + 1);
                    const float fac = isk ? 0.08838834764831845f * __builtin_amdgcn_exp2f(-np1 * lg) : __builtin_amdgcn_exp2f(np1 * lg);
                    const f32x4* cs = (const f32x4*)(CS + (size_t)row * 64 + jb);
                    const f32x4 c01 = cs[0], c23 = cs[1], c45 = cs[2], c67 = cs[3];
                    const f32x4 x1a = acc[ai][0][m][0], x1b = acc[ai][0][m][1], x2a = acc[ai][1][m][0], x2b = acc[ai][1][m][1];
                    f32x4 o1a, o1b, o2a, o2b;
                    o1a[0] = x1a[0] * c01[0] - x2a[0] * c01[1]; o2a[0] = x2a[0] * c01[0] + x1a[0] * c01[1];
                    o1a[1] = x1a[1] * c01[2] - x2a[1] * c01[3]; o2a[1] = x2a[1] * c01[2] + x1a[1] * c01[3];
                    o1a[2] = x1a[2] * c23[0] - x2a[2] * c23[1]; o2a[2] = x2a[2] * c23[0] + x1a[2] * c23[1];
                    o1a[3] = x1a[3] * c23[2] - x2a[3] * c23[3]; o2a[3] = x2a[3] * c23[2] + x1a[3] * c23[3];
                    o1b[0] = x1b[0] * c45[0] - x2b[0] * c45[1]; o2b[0] = x2b[0] * c45[0] + x1b[0] * c45[1];
                    o1b[1] = x1b[1] * c45[2] - x2b[1] * c45[3]; o2b[1] = x2b[1] * c45[2] + x1b[1] * c45[3];
                    o1b[2] = x1b[2] * c67[0] - x2b[2] * c67[1]; o2b[2] = x2b[2] * c67[0] + x1b[2] * c67[1];
                    o1b[3] = x1b[3] * c67[2] - x2b[3] * c67[3]; o2b[3] = x2b[3] * c67[2] + x1b[3] * c67[3];
                    bf16_t* rowp = base + (size_t)row * D;
                    *(u32x4*)(rowp) = pack8(o1a, o1b, fac); *(u32x4*)(rowp + 64) = pack8(o2a, o2b, fac);
                }
        }
    }
};
__device__ __forceinline__ float silu_f(float x) { return x * __builtin_amdgcn_rcpf(1.0f + __builtin_amdgcn_exp2f(-x * LOG2E)); }
struct EpiUp {
    bf16_t* HID; const f32x2* WTS; float wsc, isc;
    __device__ __forceinline__ void operator()(const f32x4 (&acc)[2][2][4][2], const UnitG& u, int wr, int wc, int fr, int fq) const {
        const int ct = u.pn, wsel = ct >> 2, col0 = wsel * 512 + (ct & 3) * 128 + wc * 32 + 8 * fq; const float c1 = -isc * LOG2E;
        float wv[2][4];
#pragma unroll
        for (int ai = 0; ai < 2; ++ai)
#pragma unroll
            for (int m = 0; m < 4; ++m) { const int r = ai * HALF + wr * 64 + m * 16 + fr; wv[ai][m] = ((const float*)WTS)[2 * (u.x0 + (r < u.x1 ? r : 0)) + wsel]; }
#pragma unroll
        for (int ai = 0; ai < 2; ++ai)
#pragma unroll
            for (int m = 0; m < 4; ++m) {
                const int r = ai * HALF + wr * 64 + m * 16 + fr;
                if (r < u.x1) {
                    const float kk = wv[ai][m] * wsc * isc * isc;
                    const f32x4 g0 = acc[ai][0][m][0], g1 = acc[ai][0][m][1], u0 = acc[ai][1][m][0], u1 = acc[ai][1][m][1];
                    f32x2 h[4];
#pragma unroll
                    for (int p = 0; p < 4; ++p) {
                        const f32x2 G = (p < 2) ? (f32x2){g0[2 * p], g0[2 * p + 1]} : (f32x2){g1[2 * p - 4], g1[2 * p - 3]};
                        const f32x2 U = (p < 2) ? (f32x2){u0[2 * p], u0[2 * p + 1]} : (f32x2){u1[2 * p - 4], u1[2 * p - 3]};
                        const f32x2 Z = G * c1; f32x2 Dn = (f32x2){__builtin_amdgcn_exp2f(Z.x), __builtin_amdgcn_exp2f(Z.y)}; Dn = Dn + 1.0f;
                        const f32x2 R = (f32x2){__builtin_amdgcn_rcpf(Dn.x), __builtin_amdgcn_rcpf(Dn.y)};
                        h[p] = (G * U) * (R * kk); }
                    u32x2 o8; o8.x = pk4_fp8(h[0].x, h[0].y, h[1].x, h[1].y); o8.y = pk4_fp8(h[2].x, h[2].y, h[3].x, h[3].y);
                    *(u32x2*)((unsigned char*)HID + (size_t)(u.pm * BM + r) * D + col0) = o8;
                }
            }
    }
};
struct EpiDown {
    bf16_t* Y; const int* LIST; float osc;
    __device__ __forceinline__ void operator()(const f32x4 (&acc)[2][2][4][2], const UnitG& u, int wr, int wc, int fr, int fq) const {
        const int col0 = u.pn * BM + wc * 32 + 8 * fq;
        int tk[2][4];
#pragma unroll
        for (int ai = 0; ai < 2; ++ai)
#pragma unroll
            for (int m = 0; m < 4; ++m) { const int r = ai * HALF + wr * 64 + m * 16 + fr; tk[ai][m] = LIST[u.x0 + (r < u.x1 ? r : 0)]; }
#pragma unroll
        for (int ai = 0; ai < 2; ++ai)
#pragma unroll
            for (int m = 0; m < 4; ++m) {
                const int r = ai * HALF + wr * 64 + m * 16 + fr;
                if (r < u.x1) {
                    const int tok = tk[ai][m]; bf16_t* rowp = Y + (size_t)tok * D + col0;
#pragma unroll
                    for (int bj = 0; bj < 2; ++bj) *(u32x4*)(rowp + bj * HALF) = pack8(acc[ai][bj][m][0], acc[ai][bj][m][1], osc);
                }
            }
    }
};
}

constexpr size_t MiB = 1u << 20;
constexpr size_t WS_CTL = 0, ZERO_BYTES = 1 * MiB;
constexpr size_t WS_CS = 2 * MiB;
constexpr size_t WS_WQKV = 18 * MiB, WS_WSO = 30 * MiB, WS_WRI = 34 * MiB, WS_WRO = 58 * MiB;
constexpr size_t WS_WGU = 66 * MiB, WS_WD = 98 * MiB;
constexpr size_t WS_XN = 114 * MiB;
constexpr size_t WS_PROJ = 178 * MiB;
constexpr size_t WS_LIST = 562 * MiB, WS_WTS = 565 * MiB, WS_XB = 577 * MiB, WS_XN8 = 641 * MiB, WS_ADAP = 673 * MiB, WS_ADA = 685 * MiB, WS_RWB = 686 * MiB, WS_END = 687 * MiB;
constexpr size_t PJ_Q = 0, PJ_K = 64 * MiB, PJ_V = 128 * MiB;
constexpr size_t PJ_RQ = 0, PJ_RK = 64 * MiB, PJ_RV = 128 * MiB, PJ_RG = 256 * MiB;
constexpr size_t PJ_HID = 0, PJ_Y2 = 128 * MiB;
constexpr int CW_BAR = 4096, CW_GCNT = 16384;
constexpr int RING_BYTES = 131072, LDSCTL_OFF = RING_BYTES, TBL_OFF = RING_BYTES + 1024, LDS_BYTES = 149504;
constexpr int RST_OFF = 36864, RST_ROW = 2064, RST_WAVE = 4 * RST_ROW;
constexpr int MAXU = 6;

#define XB_TMO      128
#define XB_XCNT(j)  (256  + 64 * (j))
#define XB_XSUB(j)  (1280 + 64 * (j))
#define XB_XGEN(j)  (2304 + 64 * (j))
#define XB_TOP      3328
#define XB_TOPGEN   3392
#define XCD_BAR_WORDS 3456
#define XB_SPIN_CAP (1u << 18)
__device__ __forceinline__ unsigned xb_ld(unsigned* p)              { return __hip_atomic_load(p, __ATOMIC_RELAXED, __HIP_MEMORY_SCOPE_AGENT); }
__device__ __forceinline__ unsigned xb_add(unsigned* p, unsigned v) { return __hip_atomic_fetch_add(p, v, __ATOMIC_RELAXED, __HIP_MEMORY_SCOPE_AGENT); }
__device__ __forceinline__ unsigned xb_xcc_id() { return (unsigned)__builtin_amdgcn_s_getreg((3 << 11) | 20) & 0xFu; }
#define XB_SPIN(cond, bar) do { unsigned _sp = 0; while (cond) { __builtin_amdgcn_s_sleep(1); \
    if ((++_sp & 255u) == 0u) { if (xb_ld(&(bar)[XB_TMO])) break; if (_sp > XB_SPIN_CAP) { atomicAdd(&(bar)[XB_TMO], 1u); break; } } } } while (0)
struct XcdBarrier { unsigned* bar; unsigned x; volatile LAS unsigned* st; };
__device__ __forceinline__ XcdBarrier xcd_barrier_post(unsigned* bar, volatile LAS unsigned* st) {
    XcdBarrier b; b.bar = bar; b.x = xb_xcc_id(); b.st = st;
    if (threadIdx.x == 0) (void)xb_add(&bar[XB_XCNT(b.x)], 1u);
    return b;
}
__device__ __forceinline__ void xcd_barrier_complete(unsigned* bar, unsigned x, unsigned& nloc, unsigned& nx) {
    const unsigned G = gridDim.x * gridDim.y * gridDim.z;
    unsigned sum, cnt, mine, sp = 0u;
    for (;;) {
        sum = 0u; cnt = 0u; mine = 0u;
#pragma unroll
        for (unsigned j = 0; j < 16; ++j) { const unsigned c = xb_ld(&bar[XB_XCNT(j)]); sum += c; cnt += (c > 0u) ? 1u : 0u; mine = (j == x) ? c : mine; }
        if (sum == G) break;
        __builtin_amdgcn_s_sleep(1);
        if ((++sp & 255u) == 0u) { if (xb_ld(&bar[XB_TMO])) break; if (sp > XB_SPIN_CAP) { atomicAdd(&bar[XB_TMO], 1u); break; } }
    }
    nloc = mine > 0u ? mine : 1u; nx = cnt > 0u ? cnt : 1u;
}
__device__ __forceinline__ void xcd_barrier(const XcdBarrier& b) {
    asm volatile("s_waitcnt vmcnt(0)" ::: "memory");
    __syncthreads();
    if (threadIdx.x == 0) {
        unsigned* bar = b.bar;
        __builtin_amdgcn_s_waitcnt(0);
        unsigned nloc = b.st[0], nx = b.st[1];
        if (nloc == 0u) { xcd_barrier_complete(bar, b.x, nloc, nx); b.st[0] = nloc; b.st[1] = nx; }
        const unsigned old = xb_add(&bar[XB_XSUB(b.x)], 1u);
        const unsigned gen = old / nloc;
        if (old + 1u == (gen + 1u) * nloc) {
            __builtin_amdgcn_fence(__ATOMIC_RELEASE, "agent");
            asm volatile("s_waitcnt vmcnt(0)" ::: "memory");
            const unsigned og = xb_add(&bar[XB_TOP], 1u);
            const unsigned tg = og / nx;
            if (og + 1u == (tg + 1u) * nx) xb_add(&bar[XB_TOPGEN], 1u);
            else XB_SPIN(xb_ld(&bar[XB_TOPGEN]) == tg, bar);
            __builtin_amdgcn_fence(__ATOMIC_ACQUIRE, "agent");
            xb_add(&bar[XB_XGEN(b.x)], 1u);
            asm volatile("s_waitcnt vmcnt(0)" ::: "memory");
        } else {
            XB_SPIN(xb_ld(&bar[XB_XGEN(b.x)]) == gen, bar);
            __builtin_amdgcn_fence(__ATOMIC_ACQUIRE, "agent");
            asm volatile("s_waitcnt vmcnt(0)" ::: "memory");
        }
    }
    __syncthreads();
}

typedef const __attribute__((address_space(4))) unsigned long long* kptr_t;
__device__ __forceinline__ const void* kin(int k) { kptr_t p = (kptr_t)__builtin_amdgcn_kernarg_segment_ptr(); asm volatile("" : "+s"(p)); return (const void*)(const GAS char*)p[k]; }
namespace gp { __device__ __forceinline__ unsigned char* skew_scratch() { int c = blockIdx.x; asm volatile("" : "+s"(c)); const int sg = (c >> 4) & 3;
    return (unsigned char*)kin(18) + WS_WGU + (size_t)(((c >> 6) * 3 + (sg - 1)) * 16 + (c & 15)) * 262144; } }
struct Frame {
    LAS unsigned char* lds; unsigned char* ws; unsigned* ctl;
    int tid, lane, wave, wave0, vcu, G, bx;
    float* out;
};
#define DPPADD(v, ctrl, rm) ((v) + __int_as_float(__builtin_amdgcn_update_dpp(0, __float_as_int(v), (ctrl), (rm), 0xf, false)))
__device__ __forceinline__ float row_total(float v) { v = DPPADD(v, 0xB1, 0xf); v = DPPADD(v, 0x4E, 0xf); v = DPPADD(v, 0x141, 0xf); v = DPPADD(v, 0x140, 0xf); return v; }
__device__ __forceinline__ float wave_total(float v) { v = row_total(v); v = DPPADD(v, 0x142, 0xa); v = DPPADD(v, 0x143, 0xc); return __int_as_float(__builtin_amdgcn_readlane(__float_as_int(v), 63)); }
__device__ __forceinline__ float shx(float v, int o, int lane) { return __int_as_float(__builtin_amdgcn_ds_bpermute((lane ^ o) << 2, __float_as_int(v))); }
__device__ __forceinline__ float wave_sum(float v, int lane) {
#pragma unroll
    for (int o = 1; o < 64; o <<= 1) v += shx(v, o, lane);
    return v;
}
__device__ __forceinline__ void tr_item(const float* Wsrc, int ldw, bf16_t* dst, int ldd, LAS float* scr, int lane) {
    f32x4 w[8];
#pragma unroll
    for (int r = 0; r < 8; ++r) { const int idx = r * 64 + lane; w[r] = *(const f32x4*)(Wsrc + (size_t)(idx >> 3) * ldw + 4 * (idx & 7)); }
#pragma unroll
    for (int r = 0; r < 8; ++r) { const int idx = r * 64 + lane; LAS float* d = scr + (idx >> 3) * 33 + 4 * (idx & 7); d[0] = w[r][0]; d[1] = w[r][1]; d[2] = w[r][2]; d[3] = w[r][3]; }
    LDS_WAIT(); asm volatile("" ::: "memory");
    const int c = lane & 7;
#pragma unroll
    for (int j = 0; j < 4; ++j) { const int n = (lane >> 3) + 8 * j; const LAS float* s = scr + (8 * c) * 33 + n;
        u32x4 o; o.x = cvtpk(s[0 * 33], s[1 * 33]); o.y = cvtpk(s[2 * 33], s[3 * 33]); o.z = cvtpk(s[4 * 33], s[5 * 33]); o.w = cvtpk(s[6 * 33], s[7 * 33]);
        *(GAS u32x4*)(dst + (size_t)n * ldd + 8 * c) = o; }
    LDS_WAIT(); asm volatile("" ::: "memory");
}
__device__ __forceinline__ void tr_item8(const float* Wsrc, int ldw, unsigned char* dst, int ldd, float scale, LAS float* scr, int lane) {
    f32x4 w[8];
#pragma unroll
    for (int r = 0; r < 8; ++r) { const int idx = r * 64 + lane; w[r] = *(const f32x4*)(Wsrc + (size_t)(idx >> 3) * ldw + 4 * (idx & 7)); }
#pragma unroll
    for (int r = 0; r < 8; ++r) { const int idx = r * 64 + lane; LAS float* d = scr + (idx >> 3) * 33 + 4 * (idx & 7); d[0] = w[r][0]; d[1] = w[r][1]; d[2] = w[r][2]; d[3] = w[r][3]; }
    LDS_WAIT(); asm volatile("" ::: "memory");
    const int c = lane & 7;
#pragma unroll
    for (int j = 0; j < 4; ++j) { const int n = (lane >> 3) + 8 * j; const LAS float* s = scr + (8 * c) * 33 + n;
        u32x2 o; o.x = pk4_fp8(s[0 * 33] * scale, s[1 * 33] * scale, s[2 * 33] * scale, s[3 * 33] * scale); o.y = pk4_fp8(s[4 * 33] * scale, s[5 * 33] * scale, s[6 * 33] * scale, s[7 * 33] * scale);
        *(GAS u32x2*)(dst + (size_t)n * ldd + 8 * c) = o; }
    LDS_WAIT(); asm volatile("" ::: "memory");
}
__device__ __forceinline__ void mixer_weight_item(Frame& F, int it, LAS float* scr) {
    const int half = it / 6144; int r = it % 6144; const int l = half;
    if (r < 1536) { const int kb = r / 96, nb = r % 96;
        tr_item(((const float*)kin(7)) + (size_t)l * 1024 * 3072 + (size_t)kb * 64 * 3072 + nb * 32, 3072, (bf16_t*)(F.ws + WS_WQKV) + (size_t)l * 3072 * 1024 + (size_t)nb * 32 * 1024 + kb * 64, 1024, scr, F.lane); return; }
    r -= 1536;
    if (r < 512) { const int kb = r / 32, nb = r % 32;
        tr_item8(((const float*)kin(8)) + (size_t)l * 1024 * 1024 + (size_t)kb * 64 * 1024 + nb * 32, 1024, (unsigned char*)(F.ws + WS_WSO) + (size_t)l * 2 * MiB + (size_t)nb * 32 * 1024 + kb * 64, 1024, 64.0f, scr, F.lane); return; }
    r -= 512;
    if (r < 3072) { const int kb = r / 192, nb = r % 192; const int s = nb * 32;
        int drow = s;
        if (s < 2048) { const int seg = s >> 10, head = (s >> 7) & 7, x2 = (s >> 6) & 1, j = s & 63; drow = (seg * 4 + (head >> 1)) * 256 + (x2 * 2 + (head & 1)) * 64 + j; }
        tr_item(((const float*)kin(9)) + (size_t)l * 1024 * 6144 + (size_t)kb * 64 * 6144 + s, 6144, (bf16_t*)(F.ws + WS_WRI) + (size_t)l * 6144 * 1024 + (size_t)drow * 1024 + kb * 64, 1024, scr, F.lane); return; }
    r -= 3072;
    { const int kb = r / 32, nb = r % 32;
        tr_item8(((const float*)kin(11)) + (size_t)l * 2048 * 1024 + (size_t)kb * 64 * 1024 + nb * 32, 1024, (unsigned char*)(F.ws + WS_WRO) + (size_t)l * 2 * MiB + (size_t)nb * 32 * 2048 + kb * 64, 2048, 64.0f, scr, F.lane); }
}
__device__ __forceinline__ void moe_weight_item(Frame& F, int layer, int it, LAS float* scr) {
    const int kind = it / 4096, r = it % 4096, e = r / 256, q = r % 256;
    if (kind < 2) { const int kb = q / 16, nb = q % 16, f = nb * 32; const int drow = (f >> 7) * 256 + kind * 128 + (f & 127);
        const float* W = (kind == 0 ? ((const float*)kin(14)) : ((const float*)kin(15))) + ((size_t)(layer * 16 + e) * 1024 + (size_t)kb * 64) * 512 + f;
        tr_item8(W, 512, (unsigned char*)(F.ws + WS_WGU) + ((size_t)e * 1024 + drow) * 1024 + kb * 64, 1024, 64.0f, scr, F.lane);
    } else { const int kb = q / 32, nb = q % 32;
        const float* W = ((const float*)kin(16)) + ((size_t)(layer * 16 + e) * 512 + (size_t)kb * 64) * 1024 + nb * 32;
        tr_item8(W, 1024, (unsigned char*)(F.ws + WS_WD) + ((size_t)(e >> 2) * 1024 + nb * 32) * 2048 + (e & 3) * 512 + kb * 64, 2048, 64.0f, scr, F.lane); }
}
__device__ __forceinline__ void moe_weight_phase(Frame& F, int layer) {
    __syncthreads();
    LAS float* scr = (LAS float*)(F.lds + F.wave * 8448);
    const int gw = F.vcu * 8 + F.wave, NGW = F.G * 8;
    for (int it = gw; it < 12288; it += NGW) moe_weight_item(F, layer, it, scr);
}

__device__ __forceinline__ void p0_prologue(Frame& F) {
    LAS float* sc = (LAS float*)F.lds;
    for (int i = F.tid; i < 8 * 1024; i += 512) { const float v = ((const float*)kin(1))[i]; sc[i] = v / (1.0f + __expf(-v)); }
    __syncthreads();
    const int gw = F.vcu * 8 + F.wave, NGW = F.G * 8;
    float* ADAP = (float*)(F.ws + WS_ADAP);
    for (int it = gw; it < 8 * 12 * 16; it += NGW) {
        const int ks = it & 15, cg = (it >> 4) % 12, j = it / 192;
        const float* W = ((const float*)kin(3)) + ((size_t)j * 1024 + ks * 64) * 3072 + cg * 256 + 4 * F.lane;
        f32x4 a[8];
#pragma unroll
        for (int b = 0; b < 8; ++b) a[b] = (f32x4){0.f, 0.f, 0.f, 0.f};
#pragma unroll 1
        for (int k0 = 0; k0 < 64; k0 += 8) {
            f32x4 w[8];
#pragma unroll
            for (int u = 0; u < 8; ++u) w[u] = *(const f32x4*)(W + (size_t)(k0 + u) * 3072);
#pragma unroll
            for (int u = 0; u < 8; ++u)
#pragma unroll
                for (int b = 0; b < 8; ++b) a[b] = a[b] + w[u] * sc[b * 1024 + ks * 64 + k0 + u];
        }
#pragma unroll
        for (int b = 0; b < 8; ++b) *(f32x4*)(ADAP + ((size_t)(ks * 8 + j) * 8 + b) * 3072 + cg * 256 + 4 * F.lane) = a[b];
    }
    if (F.vcu == 0) { const float* rw = (const float*)kin(12); bf16_t* RWB = (bf16_t*)(F.ws + WS_RWB);
        for (int i = F.tid; i < 16 * 1032; i += 512) { const int e = i / 1032, d = i % 1032; RWB[i] = (d < 1024) ? (bf16_t)(cvtpk(rw[d * 16 + e], 0.f) & 0xffffu) : (bf16_t)0; } }
    LAS float* scr = (LAS float*)(F.lds + 32768 + F.wave * 8448);
    for (int it = gw; it < 12288; it += NGW) mixer_weight_item(F, it, scr);
    f32x2* CS = (f32x2*)(F.ws + WS_CS);
    const float invf = 1.0f / __powf(10000.0f, (float)(2 * F.lane) * (1.0f / 128.0f));
    const int* posp = (const int*)kin(2);
    for (int row0_ = gw; row0_ < T; row0_ += 16 * NGW) {
      int pos16[16];
#pragma unroll
      for (int k = 0; k < 16; ++k) { const int rr = row0_ + k * NGW; pos16[k] = (rr < T) ? posp[rr] : 0; }
#pragma unroll
      for (int k = 0; k < 16; ++k) { const int row = row0_ + k * NGW; if (row < T) {
        const float ang = (float)pos16[k] * invf;
        const double rev = (double)ang * 0.15915494309189535; const float fr = (float)(rev - floor(rev));
        CS[(size_t)row * 64 + F.lane] = (f32x2){__builtin_amdgcn_cosf(fr), __builtin_amdgcn_sinf(fr)};
      } }
    }
}
__device__ __forceinline__ f32x4 mod_piece(Frame& F, size_t idx  , const float* bias, int which) {
    const float* P = (const float*)(F.ws + WS_ADAP) + idx; f32x4 a[8];
#pragma unroll
    for (int ks = 0; ks < 8; ++ks) a[ks] = *(const f32x4*)(P + (size_t)ks * 64 * 3072);
    asm volatile("" ::: "memory");
#pragma unroll
    for (int ks = 0; ks < 8; ++ks) a[ks] = a[ks] + *(const f32x4*)(P + (size_t)(8 + ks) * 64 * 3072);
#pragma unroll
    for (int st = 4; st >= 1; st >>= 1)
#pragma unroll
        for (int k = 0; k < st; ++k) a[k] = a[k] + a[k + st];
    const f32x4 r = a[0] + *(const f32x4*)bias + (which ? 1.0f : 0.0f);
    asm volatile("" ::: "memory");
    return r;
}
__device__ __forceinline__ void load_mod(Frame& F, int j, int b, int which, f32x4 (&v)[4]) {
    const float* A = (const float*)(F.ws + WS_ADA) + (size_t)(j * 8 + b) * 3072 + which * 1024;
#pragma unroll
    for (int q = 0; q < 4; ++q) v[q] = *(const f32x4*)(A + 512 * (q >> 1) + 8 * F.lane + 4 * (q & 1));
}
__device__ __forceinline__ void p1_mod0(Frame& F) {
    const int row0 = F.vcu * (T / F.G), b = row0 / SEQ; bf16_t* XN = (bf16_t*)(F.ws + WS_XN); bf16_t* XB = (bf16_t*)(F.ws + WS_XB);
    LAS f32x4* m0 = (LAS f32x4*)F.lds;
    { const int col = 4 * F.tid; m0[F.tid] = mod_piece(F, (size_t)b * 3072 + col, (const float*)kin(4) + col, col >= 1024 ? 1 : 0); }
    __syncthreads();
    f32x4 sh[4], sc[4];
#pragma unroll
    for (int jj = 0; jj < 4; ++jj) { sh[jj] = m0[64 * jj + F.lane]; sc[jj] = m0[256 + 64 * jj + F.lane]; }
    {
        float* A = (float*)(F.ws + WS_ADA); const float* bias = (const float*)kin(4);
        for (int p4 = F.vcu * 512 + F.tid; p4 < 8 * 8 * 3072 / 4; p4 += F.G * 512) { const int idx = 4 * p4, jb = idx / 3072, col = idx % 3072;
            *(f32x4*)(A + idx) = mod_piece(F, (size_t)idx, bias + (size_t)(jb >> 3) * 3072 + col, col >= 1024 ? 1 : 0); } }
    const float* xin = (const float*)kin(0);
    for (int r = F.wave; r < T / F.G; r += 32) {
        f32x4 xv[4][4];
#pragma unroll
        for (int q = 0; q < 4; ++q)
#pragma unroll
            for (int jj = 0; jj < 4; ++jj) { const int rr = r + 8 * q; xv[q][jj] = (rr < T / F.G) ? *(const f32x4*)(xin + (size_t)(row0 + rr) * D + 256 * jj + 4 * F.lane) : (f32x4){0.f, 0.f, 0.f, 0.f}; }
#pragma unroll
        for (int q = 0; q < 4; ++q) { const int rr = r + 8 * q; if (rr < T / F.G) { const size_t row = row0 + rr;
#pragma unroll
            for (int jj = 0; jj < 4; ++jj) { const f32x4 h = xv[q][jj] * sc[jj] + sh[jj];
                u32x2 w; w.x = cvtpk(h[0], h[1]); w.y = cvtpk(h[2], h[3]); *(u32x2*)(XN + row * D + 256 * jj + 4 * F.lane) = w;
                u32x2 wx; wx.x = cvtpk(xv[q][jj][0], xv[q][jj][1]); wx.y = cvtpk(xv[q][jj][2], xv[q][jj][3]); *(u32x2*)(XB + row * D + 256 * jj + 4 * F.lane) = wx; } } }
    }
}

__device__ __forceinline__ void ln_phase(Frame& F, const bf16_t* Y, int j, int jn, bool router, int layer) {
    bf16_t* XB = (bf16_t*)(F.ws + WS_XB); const bool final_out = (jn < 0); unsigned char* XN8 = F.ws + WS_XN8;
    const int RPW = T / F.G;
    const int row0 = F.vcu * RPW, b = row0 / SEQ; bf16_t* XNp = (bf16_t*)(F.ws + WS_XN);
    LAS bf16_t* rwb = (LAS bf16_t*)F.lds;
    LAS int* lhist = (LAS int*)(F.lds + 33280); LAS int* gbase = lhist + 32; LAS int* rinfo = lhist + 64;
    if (router) {
        const u32x4* src = (const u32x4*)(F.ws + WS_RWB); LAS u32x4* dst = (LAS u32x4*)rwb;
        for (int i = F.tid; i < 16 * 1032 * 2 / 16; i += 512) dst[i] = src[i];
        if (F.tid < 32) lhist[F.tid] = 0;
    }
    __syncthreads();
    f32x4 gt[4], lg[4], lb[4], sh[4], sc[4];
    load_mod(F, j, b, 2, gt);
    { const float* lng = (const float*)kin(5) + (size_t)j * 1024; const float* lnb = (const float*)kin(6) + (size_t)j * 1024;
#pragma unroll
      for (int q = 0; q < 4; ++q) { const int co = 512 * (q >> 1) + 8 * F.lane + 4 * (q & 1); lg[q] = *(const f32x4*)(lng + co); lb[q] = *(const f32x4*)(lnb + co); } }
    if (jn >= 0) { load_mod(F, jn, b, 0, sh); load_mod(F, jn, b, 1, sc); }
    u32x4 xv[2], xn[2], xm[2], yw[2], yn[2], ym[2];
#define LN_LOAD(XBUF, YB, rr) do { const size_t row_ = (size_t)(rr); _Pragma("unroll") for (int jj = 0; jj < 2; ++jj) { XBUF[jj] = __builtin_nontemporal_load((const u32x4*)(XB + row_ * D + 512 * jj + 8 * F.lane)); YB[jj] = __builtin_nontemporal_load((const u32x4*)(Y + row_ * D + 512 * jj + 8 * F.lane)); } } while (0)
    LN_LOAD(xn, yn, row0 + F.wave);
    if (F.wave + 8 < RPW) LN_LOAD(xm, ym, row0 + F.wave + 8);
    for (int r = F.wave; r < RPW; r += 8) {
        const size_t row = row0 + r;
#pragma unroll
        for (int jj = 0; jj < 2; ++jj) { xv[jj] = xn[jj]; yw[jj] = yn[jj]; xn[jj] = xm[jj]; yn[jj] = ym[jj]; }
        if (r + 16 < RPW) LN_LOAD(xm, ym, row + 16);
        f32x4 v[4]; float s = 0.f, s2 = 0.f;
#pragma unroll
        for (int jj = 0; jj < 2; ++jj) {
            const f32x4 y0 = {bflo(yw[jj].x), bfhi(yw[jj].x), bflo(yw[jj].y), bfhi(yw[jj].y)}, y1 = {bflo(yw[jj].z), bfhi(yw[jj].z), bflo(yw[jj].w), bfhi(yw[jj].w)};
            const f32x4 x0 = {bflo(xv[jj].x), bfhi(xv[jj].x), bflo(xv[jj].y), bfhi(xv[jj].y)}, x1 = {bflo(xv[jj].z), bfhi(xv[jj].z), bflo(xv[jj].w), bfhi(xv[jj].w)};
            v[2 * jj] = x0 * DN_ALPHA + gt[2 * jj] * y0; v[2 * jj + 1] = x1 * DN_ALPHA + gt[2 * jj + 1] * y1; }
#pragma unroll
        for (int q = 0; q < 4; ++q) s += (v[q][0] + v[q][1]) + (v[q][2] + v[q][3]);
        const float mean = wave_total(s) * (1.f / D);
#pragma unroll
        for (int q = 0; q < 4; ++q) { v[q] = v[q] - mean; s2 += (v[q][0] * v[q][0] + v[q][1] * v[q][1]) + (v[q][2] * v[q][2] + v[q][3] * v[q][3]); }
        const float rstd = 1.f / sqrtf(wave_total(s2) * (1.f / D) + LN_EPS);
#pragma unroll
        for (int q = 0; q < 4; ++q) v[q] = v[q] * rstd * lg[q] + lb[q];
#pragma unroll
        for (int jj = 0; jj < 2; ++jj) {
            if (final_out) { *(f32x4*)(F.out + row * D + 512 * jj + 8 * F.lane) = v[2 * jj]; *(f32x4*)(F.out + row * D + 512 * jj + 8 * F.lane + 4) = v[2 * jj + 1]; }
            else { u32x4 w; w.x = cvtpk(v[2 * jj][0], v[2 * jj][1]); w.y = cvtpk(v[2 * jj][2], v[2 * jj][3]); w.z = cvtpk(v[2 * jj + 1][0], v[2 * jj + 1][1]); w.w = cvtpk(v[2 * jj + 1][2], v[2 * jj + 1][3]);
                __builtin_nontemporal_store(w, (u32x4*)(XB + row * D + 512 * jj + 8 * F.lane)); } }
        if (jn >= 0) {
#pragma unroll
            for (int q = 0; q < 4; ++q) v[q] = v[q] * sc[q] + sh[q];
#pragma unroll
            for (int jj = 0; jj < 2; ++jj) { u32x4 w; w.x = cvtpk(v[2 * jj][0], v[2 * jj][1]); w.y = cvtpk(v[2 * jj][2], v[2 * jj][3]); w.z = cvtpk(v[2 * jj + 1][0], v[2 * jj + 1][1]); w.w = cvtpk(v[2 * jj + 1][2], v[2 * jj + 1][3]);
                if (!router) *(u32x4*)(XNp + row * D + 512 * jj + 8 * F.lane) = w;
                else *(LAS u32x4*)(F.lds + RST_OFF + F.wave * RST_WAVE + ((r >> 3) & 3) * RST_ROW + 1024 * jj + 16 * F.lane) = w;
                if (router) { u32x2 w8; w8.x = pk4_fp8(v[2 * jj][0], v[2 * jj][1], v[2 * jj][2], v[2 * jj][3]); w8.y = pk4_fp8(v[2 * jj + 1][0], v[2 * jj + 1][1], v[2 * jj + 1][2], v[2 * jj + 1][3]);
                    *(u32x2*)(XN8 + row * D + 512 * jj + 8 * F.lane) = w8; } }
        }
        if (router && ((r >> 3) & 3) == 3) {
            asm volatile("" ::: "memory");
            const int t = F.lane & 15, g = F.lane >> 4; const int rloc = (r - 24) + 8 * (t & 3);
            LAS const unsigned char* hrow = F.lds + RST_OFF + F.wave * RST_WAVE + (t & 3) * RST_ROW + 16 * g;
            f32x4 acc = {0.f, 0.f, 0.f, 0.f};
#pragma unroll
            for (int kk = 0; kk < 32; ++kk) { const bf16x8 hb_ = *(const LAS bf16x8*)(hrow + 64 * kk); const bf16x8 wa_ = *(const LAS bf16x8*)(rwb + (F.lane & 15) * 1032 + 32 * kk + 8 * g); acc = __builtin_amdgcn_mfma_f32_16x16x32_bf16(wa_, hb_, acc, 0, 0, 0); }
            const f32x4 rb4 = *(const f32x4*)((const float*)kin(13) + 4 * g);
            float l4[4] = {acc[0] + rb4[0], acc[1] + rb4[1], acc[2] + rb4[2], acc[3] + rb4[3]};
            float mx = fmaxf(fmaxf(l4[0], l4[1]), fmaxf(l4[2], l4[3]));
            mx = fmaxf(mx, shx(mx, 16, F.lane)); mx = fmaxf(mx, shx(mx, 32, F.lane));
            int i1 = 0; float v1 = l4[0];
#pragma unroll
            for (int i = 1; i < 4; ++i) if (l4[i] > v1) { v1 = l4[i]; i1 = i; }
            int i2 = -1; float v2 = -INFINITY;
#pragma unroll
            for (int i = 0; i < 4; ++i) if (i != i1 && (i2 < 0 || l4[i] > v2)) { v2 = l4[i]; i2 = i; }
            float bsc = __expf(v1 - mx) + __expf(v2 - mx); int bg = g;
            { const float os = shx(bsc, 16, F.lane); const int og = __builtin_amdgcn_ds_bpermute((F.lane ^ 16) << 2, bg); if (os > bsc || (os == bsc && og < bg)) { bsc = os; bg = og; } }
            { const float os = shx(bsc, 32, F.lane); const int og = __builtin_amdgcn_ds_bpermute((F.lane ^ 32) << 2, bg); if (os > bsc || (os == bsc && og < bg)) { bsc = os; bg = og; } }
            if (bg == g && t < 4) {
                const float w1 = 1.0f / (1.0f + __expf(v2 - v1)), w2 = 1.0f - w1;
                const int la = i1 < i2 ? i1 : i2, lbx = i1 < i2 ? i2 : i1; const float wa = i1 < i2 ? w1 : w2, wb = i1 < i2 ? w2 : w1;
                const int pair = (la == 0) ? (lbx - 1) : (la == 1 ? lbx + 1 : 5);
                const int bucket = g * 6 + pair;
                const int rank = __hip_atomic_fetch_add(lhist + bucket, 1, __ATOMIC_RELAXED, __HIP_MEMORY_SCOPE_WORKGROUP);
                rinfo[rloc * 4 + 0] = bucket; rinfo[rloc * 4 + 1] = rank; rinfo[rloc * 4 + 2] = __float_as_int(wa); rinfo[rloc * 4 + 3] = __float_as_int(wb);
            }
        }
    }
    if (router) {
        __syncthreads();
        unsigned* gcnt = F.ctl + CW_GCNT + layer * 64;
        if (F.tid < NBUCKET) gbase[F.tid] = (int)__hip_atomic_fetch_add(gcnt + F.tid, (unsigned)lhist[F.tid], __ATOMIC_RELAXED, __HIP_MEMORY_SCOPE_AGENT);
        __syncthreads();
        int* LIST = (int*)(F.ws + WS_LIST); f32x2* WTS = (f32x2*)(F.ws + WS_WTS);
        for (int r = F.tid; r < RPW; r += 512) { const int bucket = rinfo[r * 4 + 0], pos = gbase[bucket] + rinfo[r * 4 + 1];
            LIST[(size_t)bucket * T + pos] = row0 + r; WTS[(size_t)bucket * T + pos] = (f32x2){__int_as_float(rinfo[r * 4 + 2]), __int_as_float(rinfo[r * 4 + 3])}; }
    }
#undef LN_LOAD
}

__device__ __forceinline__ void gate_phase(Frame& F, int rl) {
    const bf16_t* RV = (const bf16_t*)(F.ws + WS_PROJ + PJ_RV); const bf16_t* RG = (const bf16_t*)(F.ws + WS_PROJ + PJ_RG); unsigned char* A8 = F.ws + WS_PROJ + PJ_RK;
    const float* gn = ((const float*)kin(10)) + (size_t)rl * 2048;
    const int gw = F.vcu * 8 + F.wave, NGW = F.G * 8;
    u32x4 ow[4], gv[4], on[4], gnx[4];
    f32x4 gnv[4][2];
#pragma unroll
    for (int jj = 0; jj < 4; ++jj) { gnv[jj][0] = *(const f32x4*)(gn + jj * 512 + F.lane * 8); gnv[jj][1] = *(const f32x4*)(gn + jj * 512 + F.lane * 8 + 4); }
#define GT_LOAD(OB, GB, rr) do { _Pragma("unroll") for (int jj = 0; jj < 4; ++jj) { const size_t off_ = (size_t)(rr) * 2048 + jj * 512 + F.lane * 8; OB[jj] = __builtin_nontemporal_load((const u32x4*)(RV + off_)); GB[jj] = __builtin_nontemporal_load((const u32x4*)(RG + off_)); } } while (0)
    if (gw < T) GT_LOAD(on, gnx, gw);
    for (int row = gw; row < T; row += NGW) {
#pragma unroll
        for (int jj = 0; jj < 4; ++jj) { ow[jj] = on[jj]; gv[jj] = gnx[jj]; }
        if (row + NGW < T) GT_LOAD(on, gnx, row + NGW);
#pragma unroll
        for (int jj = 0; jj < 4; ++jj) {
            const size_t off = (size_t)row * 2048 + jj * 512 + F.lane * 8;
            const u32x4 o4 = ow[jj], gw4 = gv[jj];
            float o[8] = {bflo(o4.x), bfhi(o4.x), bflo(o4.y), bfhi(o4.y), bflo(o4.z), bfhi(o4.z), bflo(o4.w), bfhi(o4.w)};
            const float g[8] = {bflo(gw4.x), bfhi(gw4.x), bflo(gw4.y), bfhi(gw4.y), bflo(gw4.z), bfhi(gw4.z), bflo(gw4.w), bfhi(gw4.w)};
            float s = 0.f;
#pragma unroll
            for (int i = 0; i < 8; ++i) s += o[i];
            s = row_total(s); s += shx(s, 16, F.lane);
            const float mu = s * (1.f / 256.f); float q = 0.f;
#pragma unroll
            for (int i = 0; i < 8; ++i) { o[i] -= mu; q += o[i] * o[i]; }
            q = row_total(q); q += shx(q, 16, F.lane);
            const float rstd = 1.f / sqrtf(q * (1.f / 256.f) + LN_EPS);
            const f32x4 g0 = gnv[jj][0], g1 = gnv[jj][1];
            float r[8];
#pragma unroll
            for (int i = 0; i < 8; ++i) r[i] = o[i] * rstd * (i < 4 ? g0[i] : g1[i - 4]) * gp::silu_f(g[i]);
#pragma unroll
            for (int i = 0; i < 8; ++i) r[i] = __builtin_amdgcn_fmed3f(r[i] * 16.0f, -440.0f, 440.0f);
            u32x2 w8; w8.x = pk4_fp8(r[0], r[1], r[2], r[3]); w8.y = pk4_fp8(r[4], r[5], r[6], r[7]);
            *(u32x2*)(A8 + (size_t)row * 2048 + jj * 512 + F.lane * 8) = w8;
        }
    }
#undef GT_LOAD
}

namespace sb {
constexpr int SLOTB = 8192, NSLOT = 3, L_K = 0, L_V = NSLOT * SLOTB, L_FLAG = 2 * NSLOT * SLOTB, L_OST = L_FLAG + 256;
__device__ __forceinline__ int crow(int r, int hi) { return (r & 3) + 8 * (r >> 2) + 4 * hi; }
__device__ __forceinline__ float fadd_s(float a, float b) { float r; asm("v_add_f32_e32 %0, %1, %2" : "=v"(r) : "v"(a), "v"(b)); return r; }
#define SB_WAIT_BAR(N) asm volatile("s_waitcnt vmcnt(" #N ") lgkmcnt(0)\n\ts_barrier" ::: "memory")
__device__ __forceinline__ void unit(int tid, int b, int h, int qb, const bf16_t* Q, const bf16_t* K, const bf16_t* V, unsigned char* O8, LAS unsigned char* lds, const bool pre, const int nxb, const int nxh, const int nxqb, unsigned long long& tacc, const int pcls) {
    const int lane = tid & 63, r32 = lane & 31, hi = lane >> 5; const int wid = __builtin_amdgcn_readfirstlane(tid >> 6);
    const long rowbase = (long)b * SEQ; const int q0 = qb * 256;
    const bf16_t* Qw = Q + (rowbase + q0 + wid * 32) * D + h * 64;
    const bf16_t* Kh = K + rowbase * D + h * 64; const bf16_t* Vh = V + rowbase * D + h * 64;
    const int kkey = 8 * wid + (lane >> 3);
    const bf16_t* ksrc = Kh + (long)kkey * D + (((lane & 7) ^ ((kkey >> 1) & 7)) * 8);
    const bf16_t* vsrc = Vh + (long)(16 * (wid & 3) + (lane >> 2)) * D + (wid >> 2) * 32 + (lane & 3) * 8;
#define SB_DMA(t, slot) do { \
        __builtin_amdgcn_global_load_lds((const unsigned*)(ksrc + (long)(t) * 64 * D), (LAS unsigned*)(lds + L_K + (slot) * SLOTB + wid * 1024), 16, 0, 0); \
        __builtin_amdgcn_global_load_lds((const unsigned*)(vsrc + (long)(t) * 64 * D), (LAS unsigned*)(lds + L_V + (slot) * SLOTB + wid * 1024), 16, 0, 0); } while (0)
    const int t0 = 4 * qb + 3;
    if (!pre) { SB_DMA(t0, 0); SB_DMA(t0 - 1, 1); }
    bf16x8 qr[4];
#pragma unroll
    for (int d0 = 0; d0 < 4; ++d0) qr[d0] = *(const bf16x8*)(Qw + (long)r32 * D + d0 * 16 + hi * 8);
    f32x16 o0 = {}, o1 = {}; float carry = 0.f; int wdone = 0;
    const int qlo = q0 + 32 * wid, qme = qlo + r32;
    LAS int* flags = (LAS int*)(lds + L_FLAG);
    const LAS unsigned char* kp0 = lds + L_K + r32 * 128 + 16 * (hi ^ ((r32 >> 1) & 7));
    const unsigned vb0 = (unsigned)(size_t)(lds + L_V) + ((lane >> 4) & 1) * 32 + (lane & 3) * 8 + (4 * hi + ((lane & 15) >> 2)) * 64;
    int sl = 0;
    for (int j = t0; j >= 0; --j) {
        { const unsigned long long t0_ = pcls ? __builtin_amdgcn_s_memrealtime() : 0ull; if (j >= 1) SB_WAIT_BAR(2); else SB_WAIT_BAR(0); if (pcls == 20) tacc += __builtin_amdgcn_s_memrealtime() - t0_; }
        const unsigned long long t1_ = (pcls == 21) ? __builtin_amdgcn_s_memrealtime() : 0ull;
        if (j < t0) { const LAS int* fl = flags + ((j + 1) & 1) * 8; int all = 1;
#pragma unroll
            for (int w = 0; w < 8; ++w) all &= fl[w];
            if (__builtin_amdgcn_readfirstlane(all)) break; }
        { const int s2 = (sl >= 1) ? sl - 1 : 2; if (j >= 2) SB_DMA(j - 2, s2); }
        const int kmin = 64 * j;
        if (kmin < qlo + 31 && !wdone) {
            const unsigned kpo = (unsigned)(kp0 - lds) + sl * SLOTB;
            f32x16 p0 = {}, p1 = {};
#pragma unroll
            for (int d0 = 0; d0 < 4; ++d0) { const unsigned ko = kpo ^ ((unsigned)d0 << 5); const bf16x8 k0 = *(const LAS bf16x8*)(lds + ko), k1 = *(const LAS bf16x8*)(lds + ko + 4096);
                p0 = __builtin_amdgcn_mfma_f32_32x32x16_bf16(k0, qr[d0], p0, 0, 0, 0); p1 = __builtin_amdgcn_mfma_f32_32x32x16_bf16(k1, qr[d0], p1, 0, 0, 0); }
            f32x16 l0, l1;
            asm volatile("s_nop 15\n\ts_nop 7" : "+v"(p0), "+v"(p1));
#pragma unroll
            for (int r = 0; r < 16; ++r) { float za, zb; asm("v_min_f32_e32 %0, 0x42c80000, %1" : "=v"(za) : "v"(p0[r])); asm("v_min_f32_e32 %0, 0x42c80000, %1" : "=v"(zb) : "v"(p1[r])); p0[r] = za; p1[r] = zb;
                l0[r] = __builtin_amdgcn_logf(1.0f + __builtin_amdgcn_exp2f(za)); l1[r] = __builtin_amdgcn_logf(1.0f + __builtin_amdgcn_exp2f(zb)); }
            if (kmin + 63 >= qlo) {
#pragma unroll
                for (int r = 0; r < 16; ++r) { const int kv = kmin + crow(r, hi);
                    if (kv >= qme) { p0[r] = -INFINITY; l0[r] = 0.f; } if (kv + 32 >= qme) { p1[r] = -INFINITY; l1[r] = 0.f; } }
            }
            float bs[8], pm[8], tt[8];
#pragma unroll
            for (int g = 0; g < 4; ++g) { bs[g] = fadd_s(fadd_s(l0[4 * g], l0[4 * g + 1]), fadd_s(l0[4 * g + 2], l0[4 * g + 3])); bs[4 + g] = fadd_s(fadd_s(l1[4 * g], l1[4 * g + 1]), fadd_s(l1[4 * g + 2], l1[4 * g + 3])); }
#pragma unroll
            for (int g = 0; g < 8; ++g) { auto rr = __builtin_amdgcn_permlane32_swap(__float_as_uint(bs[g]), __float_as_uint(bs[g]), false, false);
                const float lo = __uint_as_float(rr[0]), up = __uint_as_float(rr[1]); tt[g] = fadd_s(lo, up); pm[g] = hi ? 0.f : up; }
            float sp = carry;
#pragma unroll
            for (int g = 7; g >= 0; --g) {
                const float base = sp + pm[g];
                if (g >= 4) { const int q = 4 * (g - 4); const float c3 = base + l1[q + 3], c2 = c3 + l1[q + 2], c1 = c2 + l1[q + 1], c0 = c1 + l1[q];
                    p1[q + 3] = __builtin_amdgcn_exp2f(p1[q + 3] - c3); p1[q + 2] = __builtin_amdgcn_exp2f(p1[q + 2] - c2); p1[q + 1] = __builtin_amdgcn_exp2f(p1[q + 1] - c1); p1[q] = __builtin_amdgcn_exp2f(p1[q] - c0);
                } else { const int q = 4 * g; const float c3 = base + l0[q + 3], c2 = c3 + l0[q + 2], c1 = c2 + l0[q + 1], c0 = c1 + l0[q];
                    p0[q + 3] = __builtin_amdgcn_exp2f(p0[q + 3] - c3); p0[q + 2] = __builtin_amdgcn_exp2f(p0[q + 2] - c2); p0[q + 1] = __builtin_amdgcn_exp2f(p0[q + 1] - c1); p0[q] = __builtin_amdgcn_exp2f(p0[q] - c0); }
                sp += tt[g];
            }
            carry = sp;
            u32x4 pw0, pw1, pw2, pw3;
            pw0 = (u32x4){cvtpk(p0[0], p0[1]), cvtpk(p0[2], p0[3]), cvtpk(p0[4], p0[5]), cvtpk(p0[6], p0[7])}; pw1 = (u32x4){cvtpk(p0[8], p0[9]), cvtpk(p0[10], p0[11]), cvtpk(p0[12], p0[13]), cvtpk(p0[14], p0[15])};
            pw2 = (u32x4){cvtpk(p1[0], p1[1]), cvtpk(p1[2], p1[3]), cvtpk(p1[4], p1[5]), cvtpk(p1[6], p1[7])}; pw3 = (u32x4){cvtpk(p1[8], p1[9]), cvtpk(p1[10], p1[11]), cvtpk(p1[12], p1[13]), cvtpk(p1[14], p1[15])};
            const unsigned vb = vb0 + sl * SLOTB;
#pragma unroll
            for (int d0 = 0; d0 < 2; ++d0) { s16x4 lo[4], up[4];
#pragma unroll
                for (int ks = 0; ks < 4; ++ks) {
                    asm volatile("ds_read_b64_tr_b16 %0,%1 offset:%c2" : "=&v"(lo[ks]) : "v"(vb), "i"(d0 * 4096 + ks * 1024) : "memory");
                    asm volatile("ds_read_b64_tr_b16 %0,%1 offset:%c2" : "=&v"(up[ks]) : "v"(vb), "i"(d0 * 4096 + ks * 1024 + 512) : "memory"); }
                asm volatile("s_waitcnt lgkmcnt(0)" : "+v"(lo[0]), "+v"(lo[1]), "+v"(lo[2]), "+v"(lo[3]), "+v"(up[0]), "+v"(up[1]), "+v"(up[2]), "+v"(up[3]) :: "memory"); SBAR();
#define SB_PK(k) (bf16x8){lo[k][0], lo[k][1], lo[k][2], lo[k][3], up[k][0], up[k][1], up[k][2], up[k][3]}
                f32x16 oo = d0 ? o1 : o0;
                oo = __builtin_amdgcn_mfma_f32_32x32x16_bf16(__builtin_bit_cast(bf16x8, pw0), SB_PK(0), oo, 0, 0, 0);
                oo = __builtin_amdgcn_mfma_f32_32x32x16_bf16(__builtin_bit_cast(bf16x8, pw1), SB_PK(1), oo, 0, 0, 0);
                oo = __builtin_amdgcn_mfma_f32_32x32x16_bf16(__builtin_bit_cast(bf16x8, pw2), SB_PK(2), oo, 0, 0, 0);
                oo = __builtin_amdgcn_mfma_f32_32x32x16_bf16(__builtin_bit_cast(bf16x8, pw3), SB_PK(3), oo, 0, 0, 0);
                if (d0) o1 = oo; else o0 = oo;
#undef SB_PK
            }
        }
        { const int done = __all(carry > -SB_EXIT) ? 1 : 0; wdone = done; if (lane == 0) flags[(j & 1) * 8 + wid] = done; }
        if (pcls == 21) tacc += __builtin_amdgcn_s_memrealtime() - t1_;
        sl = (sl == 2) ? 0 : sl + 1;
    }
    const unsigned long long t2_ = (pcls == 22) ? __builtin_amdgcn_s_memrealtime() : 0ull;
    asm volatile("s_waitcnt vmcnt(0) lgkmcnt(0)\n\ts_barrier" ::: "memory");
    if (nxqb >= 0) { const long nrb = (long)nxb * SEQ; const int nt0 = 4 * nxqb + 3;
        const bf16_t* nk = K + nrb * D + nxh * 64 + (long)kkey * D + (((lane & 7) ^ ((kkey >> 1) & 7)) * 8);
        const bf16_t* nv = V + nrb * D + nxh * 64 + (long)(16 * (wid & 3) + (lane >> 2)) * D + (wid >> 2) * 32 + (lane & 3) * 8;
#pragma unroll
        for (int q = 0; q < 2; ++q) {
            __builtin_amdgcn_global_load_lds((const unsigned*)(nk + (long)(nt0 - q) * 64 * D), (LAS unsigned*)(lds + L_K + q * SLOTB + wid * 1024), 16, 0, 0);
            __builtin_amdgcn_global_load_lds((const unsigned*)(nv + (long)(nt0 - q) * 64 * D), (LAS unsigned*)(lds + L_V + q * SLOTB + wid * 1024), 16, 0, 0); } }
    unsigned char* Ow = O8 + (rowbase + q0 + wid * 32) * D + h * 64;
    { LAS unsigned char* stg = lds + L_OST + wid * 4096;
#pragma unroll
        for (int r = 0; r < 16; ++r) { const int orow = crow(r, hi); const unsigned w = (unsigned)__builtin_amdgcn_cvt_pk_fp8_f32(o0[r] * 64.0f, o1[r] * 64.0f, 0, false);
            stg[orow * 64 + r32] = (unsigned char)(w & 0xffu); stg[orow * 64 + 32 + r32] = (unsigned char)((w >> 8) & 0xffu); }
        asm volatile("s_waitcnt lgkmcnt(0)" ::: "memory");
#pragma unroll
        for (int i = 0; i < 2; ++i) { const int row = i * 16 + (lane >> 2), ch = lane & 3; const u32x4 v = *(const LAS u32x4*)(stg + row * 64 + ch * 16); *(u32x4*)(Ow + (long)row * D + ch * 16) = v; } }
    asm volatile("s_waitcnt lgkmcnt(0)" ::: "memory");
    if (pcls == 22) tacc += __builtin_amdgcn_s_memrealtime() - t2_;
#undef SB_DMA
}
}

namespace ret {
constexpr int KV_BYTES = 49152, V_OFF = 32768, Q_OFF = 2 * KV_BYTES, ST_OFF = TBL_OFF;
__device__ __forceinline__ unsigned offb(unsigned row, unsigned ch) { return 256u * row + 16u * (ch ^ (((row & 3) << 2) | ((row >> 2) & 3))); }
__device__ __forceinline__ void unit(int tid, int b, int h, int sl, const bf16_t* RQ, const bf16_t* RK, bf16_t* RV, LAS unsigned char* lds, unsigned long long& tacc, const int pcls) {
    const int lane = tid & 63, r32 = lane & 31, hi = lane >> 5; const int wid = __builtin_amdgcn_readfirstlane(tid >> 6);
    const int nb = (wid < 4) ? wid : 7 - wid, eb = wid >> 2, db = wid & 3;
    const long rowbase = (long)b * SEQ;
    const float lgam = __builtin_log2f(1.0f - __builtin_exp2f(-5.0f - (float)h)); const float g128 = __builtin_exp2f(128.0f * lgam);
    const int krow = 4 * wid + (lane >> 4), kx = ((lane >> 4) << 2) | (wid & 3);
    const bf16_t* ksrc = RK + (rowbase + krow) * D + h * 128 + (((lane & 15) ^ kx) * 8);
    const bf16_t* qdsrc = RQ + (rowbase + krow) * D + h * 128 + (((lane & 15) ^ kx) * 8);
    const bf16_t* vsrc = RV + (rowbase + 16 * wid + (lane >> 2)) * 2048 + h * 256 + sl * 64 + (lane & 3) * 8;
#define RT_DMA(c, buf) do { \
        _Pragma("unroll") for (int k_ = 0; k_ < 4; ++k_) __builtin_amdgcn_global_load_lds((const unsigned*)(ksrc + ((long)(c) * 128 + 32 * k_) * D), (LAS unsigned*)(lds + (buf) * KV_BYTES + (wid + 8 * k_) * 1024), 16, 0, 0); \
        _Pragma("unroll") for (int k_ = 0; k_ < 2; ++k_) __builtin_amdgcn_global_load_lds((const unsigned*)(vsrc + (long)(c) * 128 * 2048 + k_ * 32), (LAS unsigned*)(lds + (buf) * KV_BYTES + V_OFF + k_ * 8192 + wid * 1024), 16, 0, 0); } while (0)
#define RT_DMAQ(c) do { \
        _Pragma("unroll") for (int k_ = 0; k_ < 4; ++k_) __builtin_amdgcn_global_load_lds((const unsigned*)(qdsrc + ((long)(c) * 128 + 32 * k_) * D), (LAS unsigned*)(lds + Q_OFF + (wid + 8 * k_) * 1024), 16, 0, 0); } while (0)
    RT_DMA(0, 0); RT_DMAQ(0);
    { LAS u32x4* z = (LAS u32x4*)(lds + ST_OFF + wid * 2048); z[lane] = (u32x4){0u, 0u, 0u, 0u}; z[64 + lane] = (u32x4){0u, 0u, 0u, 0u}; }
    f32x16 st = {};
    const unsigned xr = ((r32 & 3) << 2) | ((r32 >> 2) & 3);
    const unsigned ka0 = 256u * r32 + 16u * ((unsigned)hi ^ xr);
    const unsigned q4 = (lane & 15) >> 2, p4 = lane & 3, blk = (lane >> 4) & 1;
    unsigned kt[2];
#pragma unroll
    for (int t = 0; t < 2; ++t) kt[t] = offb(8 * t + 4 * hi + q4, 4 * db + 2 * blk + (p4 >> 1)) + 8 * (p4 & 1);
    const unsigned vt = V_OFF + eb * 8192 + blk * 32 + p4 * 8 + (4 * hi + q4) * 64;
    const unsigned sa = (32 * eb + r32) * 256;
    const unsigned sx = (unsigned)(r32 & 15);
    const unsigned ldsb = (unsigned)(size_t)lds;
    bf16_t* osrc = RV + (rowbase + 32 * nb) * 2048 + h * 256 + sl * 64 + 32 * eb + r32;
    const LAS unsigned char* sp = lds + ST_OFF + sa;
    const LAS unsigned char* qbase = lds + Q_OFF + nb * 8192;
    constexpr int NC = SEQ / 128;
    for (int c = 0; c < NC; ++c) {
        const int buf = c & 1;
        { const unsigned long long t0_ = pcls ? __builtin_amdgcn_s_memrealtime() : 0ull;
          asm volatile("s_waitcnt vmcnt(0) lgkmcnt(0)\n\ts_barrier" ::: "memory");
          if (pcls == 16) tacc += __builtin_amdgcn_s_memrealtime() - t0_; }
        const unsigned long long t1_ = (pcls == 17) ? __builtin_amdgcn_s_memrealtime() : 0ull;
        if (c + 1 < NC) RT_DMA(c + 1, buf ^ 1);
        const unsigned kvb = ldsb + buf * KV_BYTES;
        const LAS unsigned char* kbase = lds + buf * KV_BYTES;
        f32x16 o = {};
        bf16x8 qf[8], ka[8];
#define RT_LDK(dst, mb_) do { _Pragma("unroll") for (int s_ = 0; s_ < 8; ++s_) dst[s_] = *(const LAS bf16x8*)(kbase + (mb_) * 8192 + (ka0 ^ ((unsigned)s_ << 5))); } while (0)
#define RT_LDV(mb_) do { const unsigned va_ = kvb + vt + (unsigned)(mb_) * 2048u; \
        asm volatile("ds_read_b64_tr_b16 %0,%1" : "=&v"(vl0) : "v"(va_) : "memory"); asm volatile("ds_read_b64_tr_b16 %0,%1 offset:512" : "=&v"(vu0) : "v"(va_) : "memory"); \
        asm volatile("ds_read_b64_tr_b16 %0,%1 offset:1024" : "=&v"(vl1) : "v"(va_) : "memory"); asm volatile("ds_read_b64_tr_b16 %0,%1 offset:1536" : "=&v"(vu1) : "v"(va_) : "memory"); } while (0)
        {
            bf16x8 sf[8];
#pragma unroll
            for (int s = 0; s < 8; ++s) qf[s] = *(const LAS bf16x8*)(qbase + (ka0 ^ ((unsigned)s << 5)));
#pragma unroll
            for (int s = 0; s < 8; ++s) sf[s] = *(const LAS bf16x8*)(sp + ((((unsigned)(2 * s + hi)) ^ sx) << 4));
            RT_LDK(ka, 0); SBAR();
#pragma unroll
            for (int s = 0; s < 8; ++s) o = __builtin_amdgcn_mfma_f32_32x32x16_bf16(qf[s], sf[s], o, 0, 0, 0);
            SBAR();
        }
        asm volatile("s_waitcnt lgkmcnt(0)\n\ts_barrier" : "+v"(qf[0]), "+v"(qf[1]), "+v"(qf[2]), "+v"(qf[3]), "+v"(qf[4]), "+v"(qf[5]), "+v"(qf[6]), "+v"(qf[7]) :: "memory");
        if (c + 1 < NC) RT_DMAQ(c + 1);
        {
#define RT_STEP(mb_) do { f32x16 p_ = {}; \
            _Pragma("unroll") for (int s_ = 0; s_ < 8; ++s_) p_ = __builtin_amdgcn_mfma_f32_32x32x16_bf16(ka[s_], qf[s_], p_, 0, 0, 0); \
            SBAR(); if ((mb_) < nb) { RT_LDK(ka, (mb_) + 1); } SBAR(); \
            s16x4 vl0, vu0, vl1, vu1; RT_LDV(mb_); \
            if ((mb_) == nb) { _Pragma("unroll") for (int r_ = 0; r_ < 16; ++r_) if (sb::crow(r_, hi) > r32) p_[r_] = 0.f; } \
            const u32x4 pa_ = {cvtpk(p_[0], p_[1]), cvtpk(p_[2], p_[3]), cvtpk(p_[4], p_[5]), cvtpk(p_[6], p_[7])}, pb_ = {cvtpk(p_[8], p_[9]), cvtpk(p_[10], p_[11]), cvtpk(p_[12], p_[13]), cvtpk(p_[14], p_[15])}; \
            asm volatile("s_waitcnt lgkmcnt(0)" : "+v"(vl0), "+v"(vu0), "+v"(vl1), "+v"(vu1) :: "memory"); \
            o = __builtin_amdgcn_mfma_f32_32x32x16_bf16(__builtin_bit_cast(bf16x8, pa_), ((bf16x8){vl0[0], vl0[1], vl0[2], vl0[3], vu0[0], vu0[1], vu0[2], vu0[3]}), o, 0, 0, 0); \
            o = __builtin_amdgcn_mfma_f32_32x32x16_bf16(__builtin_bit_cast(bf16x8, pb_), ((bf16x8){vl1[0], vl1[1], vl1[2], vl1[3], vu1[0], vu1[1], vu1[2], vu1[3]}), o, 0, 0, 0); SBAR(); } while (0)
            RT_STEP(0);
            if (nb >= 1) { RT_STEP(1); if (nb >= 2) { RT_STEP(2); if (nb >= 3) { RT_STEP(3); } } }
#undef RT_STEP
        }
#undef RT_LDV
#undef RT_LDK
        if (pcls == 17) tacc += __builtin_amdgcn_s_memrealtime() - t1_;
#pragma unroll
        for (int half = 0; half < 2; ++half) {
            s16x4 lo[4], up[4], vl[4], vu[4];
#pragma unroll
            for (int q = 0; q < 4; ++q) { const int ks = half * 4 + q;
                asm volatile("ds_read_b64_tr_b16 %0,%1 offset:%c2" : "=&v"(lo[q]) : "v"(kvb + kt[0]), "i"(ks * 4096) : "memory");
                asm volatile("ds_read_b64_tr_b16 %0,%1 offset:%c2" : "=&v"(up[q]) : "v"(kvb + kt[1]), "i"(ks * 4096) : "memory");
                asm volatile("ds_read_b64_tr_b16 %0,%1 offset:%c2" : "=&v"(vl[q]) : "v"(kvb + vt), "i"(ks * 1024) : "memory");
                asm volatile("ds_read_b64_tr_b16 %0,%1 offset:%c2" : "=&v"(vu[q]) : "v"(kvb + vt), "i"(ks * 1024 + 512) : "memory"); }
            asm volatile("s_waitcnt lgkmcnt(0)" : "+v"(lo[0]), "+v"(lo[1]), "+v"(lo[2]), "+v"(lo[3]), "+v"(up[0]), "+v"(up[1]), "+v"(up[2]), "+v"(up[3]),
                                                   "+v"(vl[0]), "+v"(vl[1]), "+v"(vl[2]), "+v"(vl[3]), "+v"(vu[0]), "+v"(vu[1]), "+v"(vu[2]), "+v"(vu[3]) :: "memory");
#pragma unroll
            for (int q = 0; q < 4; ++q) { const bf16x8 kf = (bf16x8){lo[q][0], lo[q][1], lo[q][2], lo[q][3], up[q][0], up[q][1], up[q][2], up[q][3]}, vf = (bf16x8){vl[q][0], vl[q][1], vl[q][2], vl[q][3], vu[q][0], vu[q][1], vu[q][2], vu[q][3]};
                st = __builtin_amdgcn_mfma_f32_32x32x16_bf16(kf, vf, st, 0, 0, 0); }
        }
#pragma unroll
        for (int r = 0; r < 16; ++r) st[r] *= g128;
        { LAS unsigned char* spw = lds + ST_OFF + sa;
#pragma unroll
            for (int g = 0; g < 4; ++g) { u32x2 w; w.x = cvtpk(st[4 * g], st[4 * g + 1]); w.y = cvtpk(st[4 * g + 2], st[4 * g + 3]);
                *(LAS u32x2*)(spw + ((((unsigned)(4 * db + g)) ^ sx) << 4) + 8 * hi) = w; } }
        { bf16_t* op = osrc + (long)c * 128 * 2048;
#pragma unroll
            for (int r = 0; r < 16; ++r) op[(long)sb::crow(r, hi) * 2048] = (bf16_t)(cvtpk(o[r], 0.f) & 0xffffu); }
    }
    asm volatile("s_waitcnt vmcnt(0) lgkmcnt(0)\n\ts_barrier" ::: "memory");
#undef RT_DMAQ
#undef RT_DMA
}
}

__device__ __forceinline__ void moe_prepare(Frame& F, int layer, int ncol, bool gather) {
    LAS int* info = (LAS int*)(F.lds + TBL_OFF); LAS int* tok = info + 64;
    const unsigned* gcnt = F.ctl + CW_GCNT + layer * 64; const int* LIST = (const int*)(F.ws + WS_LIST);
    int cnt[NBUCKET]; int RT = 0;
#pragma unroll
    for (int q = 0; q < NBUCKET; ++q) { cnt[q] = (int)__hip_atomic_load(gcnt + q, __ATOMIC_RELAXED, __HIP_MEMORY_SCOPE_AGENT); RT += (cnt[q] + 255) >> 8; }
    for (int i = 0; i < MAXU; ++i) {
        const int L = i * F.G + F.vcu;
        if (L >= RT * ncol) { if (F.tid == 0) info[i * 8] = 0; continue; }
        const int rt = L / ncol, ct = L % ncol; int bucket = 0, ti = 0, cb = 0, accT = 0;
#pragma unroll
        for (int q = 0; q < NBUCKET; ++q) { const int nbk = (cnt[q] + 255) >> 8; if (rt >= accT && rt < accT + nbk) { bucket = q; ti = rt - accT; cb = cnt[q]; } accT += nbk; }
        const int nvalid = (cb - ti * 256) < 256 ? (cb - ti * 256) : 256;
        if (F.tid == 0) { info[i * 8 + 0] = 1; info[i * 8 + 1] = rt; info[i * 8 + 2] = ct; info[i * 8 + 3] = bucket; info[i * 8 + 4] = ti; info[i * 8 + 5] = nvalid; }
        if (gather && F.tid < 256) tok[i * 256 + F.tid] = (F.tid < nvalid) ? (LIST[(size_t)bucket * T + ti * 256 + F.tid] << 10) : 0;
    }
    __syncthreads();
}
constexpr size_t PJ_XG8 = 256 * MiB;
__device__ __forceinline__ void gather_phase(Frame& F, int layer) {
    LAS int* tinfo = (LAS int*)(F.lds + TBL_OFF);
    const unsigned* gcnt = F.ctl + CW_GCNT + layer * 64; const int* LIST = (const int*)(F.ws + WS_LIST);
    int cnt[NBUCKET]; int RT = 0;
#pragma unroll
    for (int q = 0; q < NBUCKET; ++q) { cnt[q] = (int)__hip_atomic_load(gcnt + q, __ATOMIC_RELAXED, __HIP_MEMORY_SCOPE_AGENT); RT += (cnt[q] + 255) >> 8; }
    if (F.tid < 160) { const int rt = F.tid; int bucket = 0, ti = 0, cb = 0, accT = 0;
#pragma unroll
        for (int q = 0; q < NBUCKET; ++q) { const int nbk = (cnt[q] + 255) >> 8; if (rt >= accT && rt < accT + nbk) { bucket = q; ti = rt - accT; cb = cnt[q]; } accT += nbk; }
        const int nvalid = (cb - ti * 256) < 256 ? (cb - ti * 256) : 256;
        tinfo[2 * rt] = bucket * T + ti * 256; tinfo[2 * rt + 1] = (rt < RT) ? nvalid : 0; }
    __syncthreads();
    const unsigned char* XN8 = F.ws + WS_XN8; unsigned char* XG8 = F.ws + WS_PROJ + PJ_XG8;
    const int gw = F.vcu * 8 + F.wave, NGW = F.G * 8;
    for (int g0 = gw; g0 < RT * 256; g0 += 8 * NGW) {
        int tok[8];
#pragma unroll
        for (int k = 0; k < 8; ++k) { const int g = g0 + k * NGW; tok[k] = -1;
            if (g < RT * 256) { const int rt = g >> 8, r = g & 255; if (r < tinfo[2 * rt + 1]) tok[k] = LIST[tinfo[2 * rt] + r]; } }
        u32x4 v[8];
#pragma unroll
        for (int k = 0; k < 8; ++k) { v[k] = (u32x4){0u, 0u, 0u, 0u}; if (tok[k] >= 0) v[k] = __builtin_nontemporal_load((const u32x4*)(XN8 + (size_t)tok[k] * D + F.lane * 16)); }
#pragma unroll
        for (int k = 0; k < 8; ++k) { const int g = g0 + k * NGW; if (g < RT * 256) *(u32x4*)(XG8 + (size_t)g * D + F.lane * 16) = v[k]; }
    }
}
template <bool UP> struct MoeSched {
    static constexpr bool GATHER = UP, FP8 = true, SKEW = false;
    LAS const int* info; LAS const int* tok; const bf16_t* A; const bf16_t* W; int tid;
    __device__ __forceinline__ bool next(int i, gp::UnitG& u, gp::LaneVA& va) const {
        if (i >= MAXU) return false;
        if (__builtin_amdgcn_readfirstlane(info[i * 8]) == 0) return false;
        const int rt = __builtin_amdgcn_readfirstlane(info[i * 8 + 1]), ct = __builtin_amdgcn_readfirstlane(info[i * 8 + 2]), bucket = __builtin_amdgcn_readfirstlane(info[i * 8 + 3]),
                  ti = __builtin_amdgcn_readfirstlane(info[i * 8 + 4]), nvalid = __builtin_amdgcn_readfirstlane(info[i * 8 + 5]);
        const int g = bucket / 6, pr = bucket % 6; const int la = pr < 3 ? 0 : (pr < 5 ? 1 : 2), lb = pr < 3 ? pr + 1 : (pr < 5 ? pr - 1 : 3);
        u.pm = rt; u.pn = ct; u.x0 = bucket * T + ti * 256; u.x1 = nvalid;
        if constexpr (UP) {
            const int e = 4 * g + ((ct < 4) ? la : lb);
            u.a0 = (const char*)A; u.tb = TBL_OFF + 256 + i * 1024; u.b0 = (const char*)W + ((size_t)e * 1024 + (size_t)(ct & 3) * 256) * 1024; u.bjump = 0u; u.bsplit = 1 << 30;
        } else {
            u.a0 = (const char*)A + (size_t)rt * 256 * D; u.tb = 0; u.b0 = (const char*)W + (((size_t)g * 1024 + (size_t)ct * 256) * 2048 + (size_t)la * 512); u.bjump = (unsigned)(lb - la - 1) * 512u; u.bsplit = 4;
        }
        return true;
    }
};

__device__ __forceinline__ void launder(Frame& F) { int w_ = F.wave0; asm volatile("" : "+s"(w_)); unsigned m_ = ~0u; asm volatile("" : "+s"(m_)); int l_ = __builtin_amdgcn_mbcnt_hi(m_, __builtin_amdgcn_mbcnt_lo(m_, 0u)); asm volatile("" : "+v"(l_));     F.lane = l_; F.wave = w_; F.tid = w_ * 64 + l_;
    F.out = (float*)kin(17); F.ws = (unsigned char*)kin(18); F.ctl = (unsigned*)(F.ws + WS_CTL);
    int g_ = gridDim.x, bx_ = blockIdx.x; asm volatile("" : "+s"(g_), "+s"(bx_)); F.G = g_; F.bx = bx_; F.vcu = (g_ % 8 == 0) ? (bx_ % 8) * (g_ / 8) + bx_ / 8 : bx_; }
#ifndef MK_PER_PHASE
#define MK_PER_PHASE 0
#endif
constexpr int N_PHASES = 2 + 9 * DEPTH;
struct Args { const void* in[17]; float* out; unsigned char* ws; int ph_lo, ph_hi; };
__global__ void __launch_bounds__(512, 2) fwd(Args args) {
    extern __shared__ __attribute__((aligned(16))) unsigned char lds_raw[];
    Frame F;
    F.lds = (LAS unsigned char*)lds_raw; F.ws = args.ws; F.ctl = (unsigned*)(args.ws + WS_CTL);
    F.tid = threadIdx.x; F.lane = F.tid & 63; F.wave = __builtin_amdgcn_readfirstlane(F.tid >> 6); F.wave0 = F.wave;
    F.G = gridDim.x; { const int bx = blockIdx.x; F.bx = bx; F.vcu = (F.G % 8 == 0) ? (bx % 8) * (F.G / 8) + bx / 8 : bx; }
    F.out = args.out;
    for (int u = F.tid; u < (LDS_BYTES - LDSCTL_OFF) / 4; u += 512) ((LAS unsigned*)(F.lds + LDSCTL_OFF))[u] = 0u;
    __syncthreads();
    XcdBarrier bar; bar.bar = F.ctl + CW_BAR; bar.x = 0; bar.st = nullptr;
    if (!MK_PER_PHASE) bar = xcd_barrier_post(F.ctl + CW_BAR, (volatile LAS unsigned*)(F.lds + LDSCTL_OFF + 32));
    const int lo = args.ph_lo, hi = args.ph_hi;
#ifndef PH_MASK
#define PH_MASK 0xFFFF
#endif
#define IN(k) (lo <= (k) && (k) < hi)
#ifndef PROBE_CLASS
#define PROBE_CLASS 0
#endif
#ifndef PROBE_MULT
#define PROBE_MULT 2
#endif
    unsigned long long tsel = 0ull, tph0 = 0ull;
#define PT0() do { if (PROBE_CLASS) tph0 = __builtin_amdgcn_s_memrealtime(); } while (0)
#define PT1(cls) do { if (PROBE_CLASS && (cls) == PROBE_CLASS) tsel += __builtin_amdgcn_s_memrealtime() - tph0; } while (0)
#define PM(bit) (launder(F), (PH_MASK >> (bit)) & 1)
#define GRID_BAR() do { if (!MK_PER_PHASE) { XcdBarrier b2_ = bar; asm volatile("" : "+s"(b2_.bar)); xcd_barrier(b2_); } } while (0)
#define PJ (F.ws + WS_PROJ)
#define XN ((bf16_t*)(F.ws + WS_XN))

    if (PM(0) && IN(0)) { PT0(); p0_prologue(F); GRID_BAR(); PT1(7); }
    if (PM(1) && IN(1)) { PT0(); p1_mod0(F); GRID_BAR(); PT1(7); }
    for (int L = 0; L < DEPTH; ++L) {
        const int pb = 2 + 9 * L, ml = L >> 1;
        const bf16_t* Ymix;
        if ((L & 1) == 0) {
            bf16_t* Q = (bf16_t*)(PJ + PJ_Q); Ymix = (const bf16_t*)(PJ + PJ_K);
            if (PM(2) && IN(pb + 0)) {
                PT0();
                gp::SkewSched S; S.P.A = XN; S.P.Bt = (const bf16_t*)(F.ws + WS_WQKV) + (size_t)ml * 3072 * 1024; S.P.lda = D; S.P.ldb = D; S.P.tid = F.tid; S.P.so.init(T, 3072, F.G, F.bx);
                gp::EpiQKV E{Q, SB_QSCALE};
                gp::gemm_phase<gp::EpiQKV, gp::SkewSched>(F.lds, F.tid, D, D, D, S, E, tsel, 1);
                GRID_BAR(); PT1(1); PT1(8);
            }
            if (PM(3) && IN(pb + 1)) {
                PT0();
                const int NU = BATCH * 16 * (SEQ / 256);
                for (int uu = F.vcu; uu < NU; uu += F.G) { const int bh = uu >> 4, qb = uu & 15; const int un = uu + F.G; const bool hn = un < NU;
                    sb::unit(F.tid, bh >> 4, bh & 15, qb, Q, Q + (size_t)T * D, Q + (size_t)2 * T * D, PJ + 192 * MiB, F.lds, uu != F.vcu, hn ? (un >> 8) : 0, hn ? ((un >> 4) & 15) : 0, hn ? (un & 15) : -1, tsel, PROBE_CLASS); }
                asm volatile("s_barrier" ::: "memory");
                { const unsigned long long tw_ = PROBE_CLASS ? __builtin_amdgcn_s_memrealtime() : 0ull; if (PROBE_CLASS == 15) tsel += tw_ - tph0; moe_weight_phase(F, L); if (PROBE_CLASS == 13) tsel += __builtin_amdgcn_s_memrealtime() - tw_; }
                GRID_BAR(); PT1(2);
            }
        } else {
            bf16_t* RQ = (bf16_t*)(PJ + PJ_RQ); bf16_t* RK = (bf16_t*)(PJ + PJ_RK); bf16_t* RV = (bf16_t*)(PJ + PJ_RV); bf16_t* RG = (bf16_t*)(PJ + PJ_RG); Ymix = (const bf16_t*)(PJ + PJ_RQ);
            if (PM(4) && IN(pb + 0)) {
                PT0();
                gp::SkewSched S; S.P.A = XN; S.P.Bt = (const bf16_t*)(F.ws + WS_WRI) + (size_t)ml * 6144 * 1024; S.P.lda = D; S.P.ldb = D; S.P.tid = F.tid; S.P.so.init(T, 6144, F.G, F.bx);
                gp::EpiRet E{RQ, RK, RV, RG, (const f32x2*)(F.ws + WS_CS)};
                gp::gemm_phase<gp::EpiRet, gp::SkewSched>(F.lds, F.tid, D, D, D, S, E, tsel, 2);
                GRID_BAR(); PT1(1); PT1(11);
            }
            if (PM(5) && IN(pb + 1)) {
                PT0();
                for (int uu = F.vcu; uu < BATCH * 8 * 4; uu += F.G) { const int bh = uu >> 2; ret::unit(F.tid, bh >> 3, bh & 7, uu & 3, RQ, RK, RV, F.lds, tsel, PROBE_CLASS); }
                { const unsigned long long tw_ = PROBE_CLASS ? __builtin_amdgcn_s_memrealtime() : 0ull; if (PROBE_CLASS == 14) tsel += tw_ - tph0; moe_weight_phase(F, L); if (PROBE_CLASS == 13) tsel += __builtin_amdgcn_s_memrealtime() - tw_; }
                GRID_BAR(); PT1(3);
            }
            if (PM(6) && IN(pb + 2)) { PT0(); gate_phase(F, ml); GRID_BAR(); PT1(6); }
        }
        if (PM(7) && IN(pb + 3)) {
            PT0();
            if ((L & 1) == 0) {
                gp::PlainSchedT<true> S; S.A = (const bf16_t*)(PJ + 192 * MiB); S.Bt = (const bf16_t*)(F.ws + WS_WSO + (size_t)ml * 2 * MiB);
                int K8 = D / 2; asm volatile("" : "+s"(K8));
                S.lda = K8; S.ldb = K8; S.tid = F.tid; S.so.init(T, D, F.G, F.bx);
                gp::EpiY E{(bf16_t*)Ymix, 1.0f / (64.0f * 64.0f)};
                gp::gemm_phase<gp::EpiY, gp::PlainSchedT<true>>(F.lds, F.tid, K8, K8, K8, S, E, tsel, 3);
            } else {
                gp::PlainSchedT<true> S; S.A = (const bf16_t*)(PJ + PJ_RK); S.Bt = (const bf16_t*)(F.ws + WS_WRO + (size_t)ml * 2 * MiB);
                int K8 = D; asm volatile("" : "+s"(K8));
                S.lda = K8; S.ldb = K8; S.tid = F.tid; S.so.init(T, D, F.G, F.bx);
                gp::EpiY E{(bf16_t*)Ymix, 1.0f / (16.0f * 64.0f)};
                gp::gemm_phase<gp::EpiY, gp::PlainSchedT<true>>(F.lds, F.tid, K8, K8, K8, S, E, tsel, 4);
            }
            GRID_BAR(); PT1(1); PT1(12);
        }
        if (PM(8) && IN(pb + 4)) { PT0(); ln_phase(F, Ymix, 2 * L, 2 * L + 1, true, L); GRID_BAR(); PT1(4); }
        if (0 && PM(9) && IN(pb + 5)) { PT0(); gather_phase(F, L); GRID_BAR(); PT1(18); }
        if (PM(9) && IN(pb + 6)) {
            PT0();
            moe_prepare(F, L, 8, true);
            MoeSched<true> S{(LAS const int*)(F.lds + TBL_OFF), (LAS const int*)(F.lds + TBL_OFF) + 64, (const bf16_t*)(F.ws + WS_XN8), (const bf16_t*)(F.ws + WS_WGU), F.tid};
            gp::EpiUp E{(bf16_t*)(PJ + PJ_HID), (const f32x2*)(F.ws + WS_WTS), 16.0f, 1.0f / 64.0f};
            int K8 = D / 2; asm volatile("" : "+s"(K8));
            gp::gemm_phase<gp::EpiUp, MoeSched<true>>(F.lds, F.tid, K8, K8, K8, S, E, tsel, 5);
            GRID_BAR(); PT1(1); PT1(9);
        }
        if (PM(10) && IN(pb + 7)) {
            PT0();
            moe_prepare(F, L, 4, false);
            MoeSched<false> S{(LAS const int*)(F.lds + TBL_OFF), (LAS const int*)(F.lds + TBL_OFF) + 64, (const bf16_t*)(PJ + PJ_HID), (const bf16_t*)(F.ws + WS_WD), F.tid};
            gp::EpiDown E{(bf16_t*)(PJ + PJ_Y2), (const int*)(F.ws + WS_LIST), 1.0f / (16.0f * 64.0f)};
            int K8 = D / 2; asm volatile("" : "+s"(K8));
            gp::gemm_phase<gp::EpiDown, MoeSched<false>>(F.lds, F.tid, K8, K8, 2 * K8, S, E, tsel, 6);
            GRID_BAR(); PT1(1); PT1(10);
        }
        if (PM(11) && IN(pb + 8)) { PT0(); ln_phase(F, (const bf16_t*)(PJ + PJ_Y2), 2 * L + 1, (L + 1 < DEPTH) ? 2 * L + 2 : -1, false, L); if (L + 1 < DEPTH) GRID_BAR(); PT1(5); }
    }
    if (PROBE_CLASS) { const unsigned long long te = __builtin_amdgcn_s_memrealtime(); while (__builtin_amdgcn_s_memrealtime() - te < (PROBE_CLASS == 44 ? tsel / 20ull : (unsigned long long)PROBE_MULT * tsel)) __builtin_amdgcn_s_sleep(8); }
#undef IN
#undef GRID_BAR
}

__global__ void dbg_dump(const bf16_t* src, float* out) { for (size_t i = blockIdx.x * 256 + threadIdx.x; i < (size_t)T * D; i += 1024 * 256) out[i] = bf2f(src[i]); }
extern "C" void kernel_launch(void* const* d_in, const int* in_sizes, int n_in, void* d_out, int out_size, void* d_ws, size_t ws_size, hipStream_t stream) {
    static int grid = 0;
    if (grid == 0) {
        if (n_in != 17 || in_sizes[0] != T * D || out_size != T * D || ws_size < WS_END) { fprintf(stderr, "kernel_launch: unexpected shapes / workspace (%d inputs, ws %zu)\n", n_in, ws_size); grid = -1; return; }
        int dev = 0, cus = 0, per_cu = 0;
        if (hipGetDevice(&dev) != hipSuccess || hipDeviceGetAttribute(&cus, hipDeviceAttributeMultiprocessorCount, dev) != hipSuccess) { grid = -1; return; }
        if (hipFuncSetAttribute((const void*)fwd, hipFuncAttributeMaxDynamicSharedMemorySize, LDS_BYTES) != hipSuccess) { fprintf(stderr, "kernel_launch: hipFuncSetAttribute failed\n"); grid = -1; return; }
        if (hipOccupancyMaxActiveBlocksPerMultiprocessor(&per_cu, (const void*)fwd, 512, LDS_BYTES) != hipSuccess || per_cu < 1) { fprintf(stderr, "kernel_launch: occupancy query reports %d\n", per_cu); }
        (void)hipGetLastError();
        grid = cus;
        if (grid > 256) grid = 256;
        while (grid > 8 && ((T % grid) != 0 || (SEQ % (T / grid)) != 0 || (grid % 8) != 0)) --grid;
    }
    if (grid < 0) return;
    (void)hipMemsetAsync((char*)d_ws, 0, ZERO_BYTES, stream);
    Args a{};
    for (int i = 0; i < 17; ++i) a.in[i] = d_in[i];
    a.out = (float*)d_out; a.ws = (unsigned char*)d_ws;
#if MK_PER_PHASE
#ifndef DBG_STOP
#define DBG_STOP N_PHASES
#endif
#ifndef DBG_OFF
#define DBG_OFF (-1)
#endif
    for (int p = 0; p < DBG_STOP; ++p) { a.ph_lo = p; a.ph_hi = p + 1; hipLaunchKernelGGL(fwd, dim3(grid), dim3(512), LDS_BYTES, stream, a); }
    if (DBG_OFF >= 0) hipLaunchKernelGGL(dbg_dump, dim3(1024), dim3(256), 0, stream, (const bf16_t*)((const unsigned char*)d_ws + (size_t)DBG_OFF * MiB), (float*)d_out);
#else
    a.ph_lo = 0; a.ph_hi = N_PHASES;
    hipLaunchKernelGGL(fwd, dim3(grid), dim3(512), LDS_BYTES, stream, a);
#endif
}
```

```cpp
#include <hip/hip_runtime.h>
#include <cstdio>
#include <cstdint>
#include <cmath>

#define LAS __attribute__((address_space(3)))
#define GAS __attribute__((address_space(1)))
typedef unsigned short bf16_t;
typedef short bf16x8 __attribute__((ext_vector_type(8)));
typedef short s16x4 __attribute__((ext_vector_type(4)));
typedef float f32x4 __attribute__((ext_vector_type(4)));
typedef float f32x2 __attribute__((ext_vector_type(2)));
typedef float f32x16 __attribute__((ext_vector_type(16)));
typedef unsigned u32x4 __attribute__((ext_vector_type(4)));
typedef unsigned u32x2 __attribute__((ext_vector_type(2)));
typedef __bf16 bf16x2_t __attribute__((ext_vector_type(2)));
typedef int v8i __attribute__((ext_vector_type(8)));

constexpr int BATCH = 8, SEQ = 4096, D = 1024, T = BATCH * SEQ, DEPTH = 4;
constexpr int NBUCKET = 24;
constexpr float LN_EPS = 1e-5f;
constexpr float DN_ALPHA = 1.6817928305074292f;
constexpr float LOG2E = 1.4426950408889634f;
constexpr float SB_QSCALE = 0.125f * LOG2E;
constexpr float SB_EXIT = -152.0f;

__device__ __forceinline__ unsigned cvtpk(float lo, float hi) { f32x2 v = {lo, hi}; bf16x2_t b = __builtin_convertvector(v, bf16x2_t); return __builtin_bit_cast(unsigned, b); }
__device__ __forceinline__ float bf2f(unsigned short h) { return __builtin_bit_cast(float, (unsigned)h << 16); }
__device__ __forceinline__ float bflo(unsigned w) { return __builtin_bit_cast(float, w << 16); }
__device__ __forceinline__ float bfhi(unsigned w) { return __builtin_bit_cast(float, w & 0xffff0000u); }
__device__ __forceinline__ unsigned pk4_fp8(float a, float b, float c, float d) { int w = 0; w = __builtin_amdgcn_cvt_pk_fp8_f32(a, b, w, false); w = __builtin_amdgcn_cvt_pk_fp8_f32(c, d, w, true); return (unsigned)w; }
#define LDS_WAIT() asm volatile("s_waitcnt lgkmcnt(0)" ::: "memory")
#define VM_WAIT() asm volatile("s_waitcnt vmcnt(0)" ::: "memory")
#define SBAR() __builtin_amdgcn_sched_barrier(0)

#ifndef PROBE_CLASS
#define PROBE_CLASS 0
#endif
#ifndef PROBE_GSITE
#define PROBE_GSITE 0
#endif
namespace gp {
constexpr int BM = 256, BK = 64, HALF = 128, HTB = HALF * BK * 2, STAGE_BYTES = 8 * HTB, NXCD = 8, WGM = 8;
__host__ __device__ __forceinline__ int lds_byte(int r, int c) { const int st = (r >> 4) * 2 + (c >> 5), rr = r & 15, cc = c & 31, ob = rr * 64 + cc * 2; return st * 1024 + (ob ^ (((ob >> 9) & 1) << 5)); }
__host__ __device__ __forceinline__ void stage_rc(int b, int& R, int& C) { const int st = b / 1024, sb = b % 1024, swz = sb ^ (((sb >> 9) & 1) << 5); R = (st >> 1) * 16 + swz / 64; C = (st & 1) * 32 + (swz % 64) / 2; }
__host__ __device__ __forceinline__ int perm32(int rho) { const int n = rho >> 4, i = rho & 15; return 8 * (i >> 2) + 4 * n + (i & 3); }

__device__ __forceinline__ void lane_rc(int tid, int i, int& R, int& C) { stage_rc(tid * 16 + i * 8192, R, C); }
struct UnitG { int pm, pn; const char* a0; const char* b0; unsigned bjump; int bsplit; int x0, x1; int tb; };
struct LaneVA { unsigned v[2][2]; };

struct StaticOrder {
    int nM, nN, nwg, G, c;
    __device__ void init(int M, int N, int G_, int c_) { nM = M / BM; nN = N / BM; nwg = nM * nN; G = G_; c = c_; }
    __device__ bool next(int i, int& pm, int& pn) const {
        const long L = (long)i * G + c; if (L >= nwg) return false;
        int wgid = (int)L; { const int q = nwg / NXCD, r = nwg % NXCD, xcd = wgid % NXCD, off = wgid / NXCD; wgid = (xcd < r ? xcd * (q + 1) : r * (q + 1) + (xcd - r) * q) + off; }
        const int nig = WGM * nN, gid = wgid / nig, fm = gid * WGM, gsz = (nM - fm) < WGM ? (nM - fm) : WGM;
        pm = fm + ((wgid % nig) % gsz); pn = (wgid % nig) / gsz; return true;
    }
};
template <bool F8> struct PlainSchedT {
    static constexpr bool GATHER = false, FP8 = F8;
    const bf16_t* A; const bf16_t* Bt; int lda, ldb, tid; StaticOrder so; int pn_off = 0;
    __device__ __forceinline__ bool next(int i, UnitG& u, LaneVA&) const {
        int pm, pn; if (!so.next(i, pm, pn)) return false;
        u.pm = pm; u.pn = pn + pn_off; u.a0 = (const char*)A + (size_t)pm * BM * lda * 2; u.b0 = (const char*)Bt + (size_t)pn * BM * ldb * 2; u.bjump = 0u; u.bsplit = 1 << 30; u.x0 = 0; u.x1 = 0; u.tb = 0;
        return true;
    }
};
typedef PlainSchedT<false> PlainSched;

template <class Epi, class Sched>
__device__ __forceinline__ void gemm_phase(LAS unsigned char* lds, const int tid, const int K, const int lda, const int ldb, const Sched& S, const Epi& E, unsigned long long& tsel, const int gsite) {
    const int wid = __builtin_amdgcn_readfirstlane(tid >> 6), lane = tid & 63, wr = wid >> 2, wc = wid & 3, fr = lane & 15, fq = lane >> 4;
    const int nt = K / BK;
    constexpr bool GA = Sched::GATHER;
    constexpr bool F8 = Sched::FP8;
    unsigned voffA, voffB;
    { int R, C; stage_rc(tid * 16, R, C); const int Rb = (R & ~31) + perm32(R & 31); voffA = GA ? ((unsigned)(R * 4) | ((unsigned)(C * 2) << 16)) : (unsigned)(R * lda + C) * 2u; voffB = (unsigned)(Rb * ldb + C) * 2u; }
    const size_t kstep = (size_t)(BK * 2);
    const size_t hstepB = (size_t)HALF * ldb * 2, pstepB = (size_t)64 * ldb * 2;
    const size_t hstepA = (size_t)HALF * lda * 2, pstepA = (size_t)64 * lda * 2;
    const unsigned ldsw = (unsigned)wid * 1024u;
    const int aoff = lds_byte(wr * 64 + fr, fq * 8), boff = lds_byte(wc * 32 + fr, fq * 8);
    const int sub8 = (fq >> 1) * 1024 + ((fr * 64 + 32 * (fq & 1)) ^ (((fr >> 3) & 1) << 5));
    const int aoff8 = wr * 8 * 1024 + sub8, boff8 = wc * 4 * 1024 + sub8;
    int sc8 = 0x7f7f7f7f; asm volatile("" : "+v"(sc8));
#define PG8_SA(b, h) (((b) * 2 + (h)) * HTB)
#define PG8_SB(b, h) ((4 + (b) * 2 + (h)) * HTB)
#define PG8_LD1(bufoff, gptr) __builtin_amdgcn_global_load_lds((const unsigned*)(gptr), (LAS unsigned*)(lds + (bufoff) + ldsw), 16, 0, 0)
#define PG8_STAGE_B(bufoff, gbase) do { PG8_LD1(bufoff, (const char*)(gbase) + voffB); PG8_LD1((bufoff) + 8192, (const char*)(gbase) + pstepB + voffB); } while (0)
#define PG8_GTB(tb, h) do { if constexpr (GA) { const unsigned ta_ = ldsa + (unsigned)(tb) + (h) * 512 + (voffA & 0xffffu); asm volatile("ds_read2st64_b32 %0, %1 offset1:1" : "=v"(gpair) : "v"(ta_) : "memory"); } } while (0)
#define PG8_STAGE_A(bufoff, gbase, h, VA) do { if constexpr (GA) { asm volatile("s_waitcnt lgkmcnt(0)" : "+v"(gpair) :: "memory"); PG8_LD1(bufoff, (const char*)(gbase) + (gpair.x + (voffA >> 16))); PG8_LD1((bufoff) + 8192, (const char*)(gbase) + (gpair.y + (voffA >> 16))); } \
        else { PG8_LD1(bufoff, (const char*)(gbase) + (h) * hstepA + voffA); PG8_LD1((bufoff) + 8192, (const char*)(gbase) + (h) * hstepA + pstepA + voffA); } } while (0)
#define PG8_LDA(dst, b, h) do { _Pragma("unroll") for (int m = 0; m < 4; ++m) _Pragma("unroll") for (int k = 0; k < 2; ++k) dst[m][k] = *(const LAS bf16x8*)(lds + PG8_SA(b, h) + aoff + m * 2048 + k * 1024); } while (0)
#define PG8_LDB(dst, b, h) do { _Pragma("unroll") for (int n = 0; n < 2; ++n) _Pragma("unroll") for (int k = 0; k < 2; ++k) dst[n][k] = *(const LAS bf16x8*)(lds + PG8_SB(b, h) + boff + n * 2048 + k * 1024); } while (0)
#define PG8_MMA(ai, bj, At, Bt) do { __builtin_amdgcn_s_setprio(1); _Pragma("unroll") for (int m = 0; m < 4; ++m) _Pragma("unroll") for (int n = 0; n < 2; ++n) _Pragma("unroll") for (int k = 0; k < 2; ++k) \
        acc[ai][bj][m][n] = __builtin_amdgcn_mfma_f32_16x16x32_bf16(Bt[n][k], At[m][k], acc[ai][bj][m][n], 0, 0, 0); __builtin_amdgcn_s_setprio(0); } while (0)
#define PG8_LDA8(dst, b, h) do { _Pragma("unroll") for (int m = 0; m < 4; ++m) { const u32x4 x0_ = *(const LAS u32x4*)(lds + PG8_SA(b, h) + aoff8 + m * 2048), x1_ = *(const LAS u32x4*)(lds + PG8_SA(b, h) + aoff8 + m * 2048 + 16); \
        dst[m] = __builtin_bit_cast(v8i, __builtin_shufflevector(x0_, x1_, 0, 1, 2, 3, 4, 5, 6, 7)); } } while (0)
#define PG8_LDB8(dst, b, h) do { _Pragma("unroll") for (int n = 0; n < 2; ++n) { const u32x4 x0_ = *(const LAS u32x4*)(lds + PG8_SB(b, h) + boff8 + n * 2048), x1_ = *(const LAS u32x4*)(lds + PG8_SB(b, h) + boff8 + n * 2048 + 16); \
        dst[n] = __builtin_bit_cast(v8i, __builtin_shufflevector(x0_, x1_, 0, 1, 2, 3, 4, 5, 6, 7)); } } while (0)
#define PG8_MMA8(ai, bj, A8, B8) do { __builtin_amdgcn_s_setprio(1); _Pragma("unroll") for (int m = 0; m < 4; ++m) _Pragma("unroll") for (int n = 0; n < 2; ++n) \
        acc[ai][bj][m][n] = __builtin_amdgcn_mfma_scale_f32_16x16x128_f8f6f4(B8[n], A8[m], acc[ai][bj][m][n], 0, 0, 0, sc8, 0, sc8); __builtin_amdgcn_s_setprio(0); } while (0)
#define PG8_RDB(B0x, B1x, B08x, B18x, b) do { if constexpr (F8) { PG8_LDB8(B08x, b, 0); PG8_LDB8(B18x, b, 1); } else { PG8_LDB(B0x, b, 0); PG8_LDB(B1x, b, 1); } } while (0)
#define PG8_RDA(b, h) do { if constexpr (F8) { PG8_LDA8(At8, b, h); } else { PG8_LDA(At, b, h); } } while (0)
#define PG8_PIN(ai) asm volatile("" : "+v"(acc[ai][0][0][0]), "+v"(acc[ai][0][0][1]), "+v"(acc[ai][0][1][0]), "+v"(acc[ai][0][1][1]), "+v"(acc[ai][0][2][0]), "+v"(acc[ai][0][2][1]), "+v"(acc[ai][0][3][0]), "+v"(acc[ai][0][3][1]), \
        "+v"(acc[ai][1][0][0]), "+v"(acc[ai][1][0][1]), "+v"(acc[ai][1][1][0]), "+v"(acc[ai][1][1][1]), "+v"(acc[ai][1][2][0]), "+v"(acc[ai][1][2][1]), "+v"(acc[ai][1][3][0]), "+v"(acc[ai][1][3][1]))
#define PG8_MM(ai) do { if constexpr (F8) { PG8_MMA8(ai, 0, At8, B08); PG8_MMA8(ai, 1, At8, B18); PG8_PIN(ai); } else { PG8_MMA(ai, 0, At, B0); PG8_MMA(ai, 1, At, B1); } } while (0)
#define PG8_F8SB do { if constexpr (F8) SBAR(); } while (0)
#define PG8_WAIT_V(n) asm volatile("s_waitcnt vmcnt(" #n ")" ::: "memory")
#define PG8_WAIT_L(n) asm volatile("s_waitcnt lgkmcnt(" #n ")" ::: "memory")
#define PG8_BAR __builtin_amdgcn_s_barrier()
#define PG8_BPTR(u, kt) ((u).b0 + (size_t)(kt) * kstep + (((kt) >= (u).bsplit) ? (size_t)(u).bjump : (size_t)0))
    UnitG cur, nxt; LaneVA cva, nva; int ui = 0; unsigned tpe = 0u; u32x2 gpair = {0u, 0u}; const unsigned ldsa = (unsigned)(size_t)lds;
    if (!S.next(0, cur, cva)) return;
    f32x4 acc[2][2][4][2];
#pragma unroll
    for (int a = 0; a < 2; ++a)
#pragma unroll
        for (int b = 0; b < 2; ++b)
#pragma unroll
            for (int m = 0; m < 4; ++m)
#pragma unroll
                for (int n = 0; n < 2; ++n) acc[a][b][m][n] = (f32x4){0.f, 0.f, 0.f, 0.f};
    bf16x8 At[4][2], B0[2][2], B1[2][2]; v8i At8[4], B08[2], B18[2];
    {
        const char* cA = cur.a0; const char* cB = cur.b0;
        PG8_STAGE_B(PG8_SB(0, 0), cB); PG8_STAGE_B(PG8_SB(0, 1), cB + hstepB); PG8_GTB(cur.tb, 0); PG8_STAGE_A(PG8_SA(0, 0), cA, 0, cva); PG8_GTB(cur.tb, 1); PG8_STAGE_A(PG8_SA(0, 1), cA, 1, cva);
        if (wr == 1) PG8_BAR;
        PG8_WAIT_V(2); PG8_BAR;
        PG8_STAGE_B(PG8_SB(1, 0), cB + kstep); PG8_GTB(cur.tb, 0); PG8_STAGE_A(PG8_SA(1, 0), cA + kstep, 0, cva); PG8_STAGE_B(PG8_SB(1, 1), cB + hstepB + kstep);
        PG8_WAIT_V(6); PG8_BAR;
    }
    for (;;) {
        const bool has_next = S.next(ui + 1, nxt, nva);
        if (!has_next) nxt = cur;
        const char* nA = nxt.a0; const char* nB = nxt.b0;
        const unsigned tk0_ = (PROBE_CLASS == 44 || PROBE_CLASS == 45) ? (PROBE_CLASS == 44 ? (unsigned)__builtin_amdgcn_s_memtime() : (unsigned)__builtin_amdgcn_s_memrealtime()) : 0u;
        for (int t = 0; t < nt; t += 2) {
            const bool last = (t == nt - 2);
            const char* a1 = cur.a0 + (size_t)(t + 1) * kstep;
            const char* a2 = last ? nA : cur.a0 + (size_t)(t + 2) * kstep; const char* b2 = last ? nB : PG8_BPTR(cur, t + 2);
            const char* a3 = a2 + kstep; const char* b3 = b2 + kstep;
            const int tb2 = last ? nxt.tb : cur.tb;
            PG8_GTB(cur.tb, 1); PG8_RDB(B0, B1, B08, B18, 0); SBAR(); PG8_RDA(0, 0); PG8_STAGE_A(PG8_SA(1, 1), a1, 1, cva);
            PG8_WAIT_V(8); PG8_WAIT_L(0); PG8_BAR; if (PROBE_CLASS == 43 && gsite == PROBE_GSITE && t == 0 && ui > 0) tsel += (unsigned)__builtin_amdgcn_s_memrealtime() - tpe; PG8_F8SB; PG8_MM(0); PG8_F8SB; PG8_BAR; SBAR();
            PG8_GTB(tb2, 0); PG8_RDA(0, 1); PG8_STAGE_B(PG8_SB(0, 0), b2); PG8_STAGE_B(PG8_SB(0, 1), b2 + hstepB); PG8_STAGE_A(PG8_SA(0, 0), a2, 0, cva);
            PG8_WAIT_V(8); PG8_WAIT_L(0); PG8_BAR; PG8_F8SB; PG8_MM(1); PG8_F8SB; PG8_BAR; SBAR();
            PG8_GTB(tb2, 1); PG8_RDB(B0, B1, B08, B18, 1); SBAR(); PG8_RDA(1, 0); PG8_STAGE_A(PG8_SA(0, 1), a2, 1, cva);
            PG8_WAIT_V(8); PG8_WAIT_L(0); PG8_BAR; PG8_F8SB; PG8_MM(0); PG8_F8SB; PG8_BAR; SBAR();
            PG8_GTB(tb2, 0); PG8_RDA(1, 1); PG8_STAGE_B(PG8_SB(1, 0), b3); PG8_STAGE_B(PG8_SB(1, 1), b3 + hstepB); PG8_STAGE_A(PG8_SA(1, 0), a3, 0, cva);
            PG8_WAIT_V(8); PG8_WAIT_L(0); PG8_BAR; PG8_F8SB; PG8_MM(1); PG8_F8SB; PG8_BAR; SBAR();
        }
        if ((PROBE_CLASS == 44 || PROBE_CLASS == 45) && gsite == PROBE_GSITE) tsel += (PROBE_CLASS == 44 ? (unsigned)__builtin_amdgcn_s_memtime() : (unsigned)__builtin_amdgcn_s_memrealtime()) - tk0_;
        if (wr == 0) PG8_BAR;
#pragma unroll
        for (int a = 0; a < 2; ++a)
#pragma unroll
            for (int b = 0; b < 2; ++b) asm volatile("" : "+v"(acc[a][b][0][0]), "+v"(acc[a][b][0][1]), "+v"(acc[a][b][1][0]), "+v"(acc[a][b][1][1]), "+v"(acc[a][b][2][0]), "+v"(acc[a][b][2][1]), "+v"(acc[a][b][3][0]), "+v"(acc[a][b][3][1]));
        if (PROBE_CLASS == 43 && gsite == PROBE_GSITE) tpe = (unsigned)__builtin_amdgcn_s_memrealtime();
        if (PROBE_CLASS == 40 && gsite == PROBE_GSITE) { const unsigned t0_ = (unsigned)__builtin_amdgcn_s_memrealtime(); E(acc, cur, wr, wc, fr, fq); asm volatile("s_waitcnt vmcnt(0)" ::: "memory"); tsel += (unsigned)__builtin_amdgcn_s_memrealtime() - t0_; } else
        E(acc, cur, wr, wc, fr, fq);
        if (PROBE_CLASS == 43 && gsite == PROBE_GSITE && !has_next) tsel += (unsigned)__builtin_amdgcn_s_memrealtime() - tpe;
        if (!has_next) break;
#pragma unroll
        for (int a = 0; a < 2; ++a)
#pragma unroll
            for (int b = 0; b < 2; ++b)
#pragma unroll
                for (int m = 0; m < 4; ++m)
#pragma unroll
                    for (int n = 0; n < 2; ++n) acc[a][b][m][n] = (f32x4){0.f, 0.f, 0.f, 0.f};
        cur = nxt; ++ui;
        if (wr == 1) PG8_BAR;
    }
    PG8_WAIT_V(0);
    PG8_BAR;
#undef PG8_SA
#undef PG8_SB
#undef PG8_LD1
#undef PG8_STAGE_A
#undef PG8_GTB
#undef PG8_STAGE_B
#undef PG8_LDA
#undef PG8_LDB
#undef PG8_MMA
#undef PG8_LDA8
#undef PG8_LDB8
#undef PG8_MMA8
#undef PG8_RDB
#undef PG8_RDA
#undef PG8_MM
#undef PG8_PIN
#undef PG8_F8SB
#undef PG8_WAIT_V
#undef PG8_WAIT_L
#undef PG8_BAR
#undef PG8_BPTR
}

__device__ __forceinline__ u32x4 pack8(const f32x4& v0, const f32x4& v1, float s) {
    u32x4 w; w.x = cvtpk(v0[0] * s, v0[1] * s); w.y = cvtpk(v0[2] * s, v0[3] * s); w.z = cvtpk(v1[0] * s, v1[1] * s); w.w = cvtpk(v1[2] * s, v1[3] * s); return w;
}
struct EpiQKV {
    bf16_t* Q; float qscale;
    __device__ __forceinline__ void operator()(const f32x4 (&acc)[2][2][4][2], const UnitG& u, int wr, int wc, int fr, int fq) const {
        const int t = u.pn >> 2; bf16_t* base = Q + (size_t)t * T * D; const float sc = (t == 0) ? qscale : 1.f;
        const int col0 = (u.pn & 3) * BM + wc * 32 + 8 * fq, row0 = u.pm * BM + wr * 64 + fr;
#pragma unroll
        for (int ai = 0; ai < 2; ++ai)
#pragma unroll
            for (int m = 0; m < 4; ++m) { bf16_t* rowp = base + (size_t)(row0 + ai * HALF + m * 16) * D + col0;
#pragma unroll
                for (int bj = 0; bj < 2; ++bj) *(u32x4*)(rowp + bj * HALF) = pack8(acc[ai][bj][m][0], acc[ai][bj][m][1], sc); }
    }
};
struct EpiY {
    bf16_t* Y; float ysc;
    __device__ __forceinline__ void operator()(const f32x4 (&acc)[2][2][4][2], const UnitG& u, int wr, int wc, int fr, int fq) const {
        const int col0 = u.pn * BM + wc * 32 + 8 * fq, row0 = u.pm * BM + wr * 64 + fr;
#pragma unroll
        for (int ai = 0; ai < 2; ++ai)
#pragma unroll
            for (int m = 0; m < 4; ++m) { bf16_t* rowp = Y + (size_t)(row0 + ai * HALF + m * 16) * D + col0;
#pragma unroll
                for (int bj = 0; bj < 2; ++bj) *(u32x4*)(rowp + bj * HALF) = pack8(acc[ai][bj][m][0], acc[ai][bj][m][1], ysc); }
    }
};
struct EpiRet {
    bf16_t *RQ, *RK, *RV, *RG; const f32x2* CS;
    __device__ __forceinline__ void operator()(const f32x4 (&acc)[2][2][4][2], const UnitG& u, int wr, int wc, int fr, int fq) const {
        const int row0 = u.pm * BM + wr * 64 + fr;
        if (u.pn >= 8) {
            bf16_t* base = (u.pn >= 16) ? RG : RV; const int col0 = (u.pn & 7) * BM + wc * 32 + 8 * fq;
#pragma unroll
            for (int ai = 0; ai < 2; ++ai)
#pragma unroll
                for (int m = 0; m < 4; ++m) { bf16_t* rowp = base + (size_t)(row0 + ai * HALF + m * 16) * 2048 + col0;
#pragma unroll
                    for (int bj = 0; bj < 2; ++bj) *(u32x4*)(rowp + bj * HALF) = pack8(acc[ai][bj][m][0], acc[ai][bj][m][1], 1.f); }
        } else {
            const bool isk = u.pn >= 4; const int head = 2 * (u.pn & 3) + (wc >> 1), jb = (wc & 1) * 32 + 8 * fq;
            const float lg = __builtin_log2f(1.0f - __builtin_exp2f(-5.0f - (float)head));
            bf16_t* base = (isk ? RK : RQ) + head * 128 + jb;
#pragma unroll
            for (int ai = 0; ai < 2; ++ai)
#pragma unroll
                for (int m = 0; m < 4; ++m) {
                    const int row = row0 + ai * HALF + m * 16; const float np1 = (float)((row & 127) + 1);
                    const float fac = isk ? 0.08838834764831845f * __builtin_amdgcn_exp2f(-np1 * lg) : __builtin_amdgcn_exp2f(np1 * lg);
                    const f32x4* cs = (const f32x4*)(CS + (size_t)row * 64 + jb);
                    const f32x4 c01 = cs[0], c23 = cs[1], c45 = cs[2], c67 = cs[3];
                    const f32x4 x1a = acc[ai][0][m][0], x1b = acc[ai][0][m][1], x2a = acc[ai][1][m][0], x2b = acc[ai][1][m][1];
                    f32x4 o1a, o1b, o2a, o2b;
                    o1a[0] = x1a[0] * c01[0] - x2a[0] * c01[1]; o2a[0] = x2a[0] * c01[0] + x1a[0] * c01[1];
                    o1a[1] = x1a[1] * c01[2] - x2a[1] * c01[3]; o2a[1] = x2a[1] * c01[2] + x1a[1] * c01[3];
                    o1a[2] = x1a[2] * c23[0] - x2a[2] * c23[1]; o2a[2] = x2a[2] * c23[0] + x1a[2] * c23[1];
                    o1a[3] = x1a[3] * c23[2] - x2a[3] * c23[3]; o2a[3] = x2a[3] * c23[2] + x1a[3] * c23[3];
                    o1b[0] = x1b[0] * c45[0] - x2b[0] * c45[1]; o2b[0] = x2b[0] * c45[0] + x1b[0] * c45[1];
                    o1b[1] = x1b[1] * c45[2] - x2b[1] * c45[3]; o2b[1] = x2b[1] * c45[2] + x1b[1] * c45[3];
                    o1b[2] = x1b[2] * c67[0] - x2b[2] * c67[1]; o2b[2] = x2b[2] * c67[0] + x1b[2] * c67[1];
                    o1b[3] = x1b[3] * c67[2] - x2b[3] * c67[3]; o2b[3] = x2b[3] * c67[2] + x1b[3] * c67[3];
                    bf16_t* rowp = base + (size_t)row * D;
                    *(u32x4*)(rowp) = pack8(o1a, o1b, fac); *(u32x4*)(rowp + 64) = pack8(o2a, o2b, fac);
                }
        }
    }
};
__device__ __forceinline__ float silu_f(float x) { return x * __builtin_amdgcn_rcpf(1.0f + __builtin_amdgcn_exp2f(-x * LOG2E)); }
struct EpiUp {
    bf16_t* HID; const f32x2* WTS; float wsc, isc;
    __device__ __forceinline__ void operator()(const f32x4 (&acc)[2][2][4][2], const UnitG& u, int wr, int wc, int fr, int fq) const {
        const int ct = u.pn, wsel = ct >> 2, col0 = wsel * 512 + (ct & 3) * 128 + wc * 32 + 8 * fq; const float c1 = -isc * LOG2E;
        float wv[2][4];
#pragma unroll
        for (int ai = 0; ai < 2; ++ai)
#pragma unroll
            for (int m = 0; m < 4; ++m) { const int r = ai * HALF + wr * 64 + m * 16 + fr; wv[ai][m] = ((const float*)WTS)[2 * (u.x0 + (r < u.x1 ? r : 0)) + wsel]; }
#pragma unroll
        for (int ai = 0; ai < 2; ++ai)
#pragma unroll
            for (int m = 0; m < 4; ++m) {
                const int r = ai * HALF + wr * 64 + m * 16 + fr;
                if (r < u.x1) {
                    const float kk = wv[ai][m] * wsc * isc * isc;
                    const f32x4 g0 = acc[ai][0][m][0], g1 = acc[ai][0][m][1], u0 = acc[ai][1][m][0], u1 = acc[ai][1][m][1];
                    f32x2 h[4];
#pragma unroll
                    for (int p = 0; p < 4; ++p) {
                        const f32x2 G = (p < 2) ? (f32x2){g0[2 * p], g0[2 * p + 1]} : (f32x2){g1[2 * p - 4], g1[2 * p - 3]};
                        const f32x2 U = (p < 2) ? (f32x2){u0[2 * p], u0[2 * p + 1]} : (f32x2){u1[2 * p - 4], u1[2 * p - 3]};
                        const f32x2 Z = G * c1; f32x2 Dn = (f32x2){__builtin_amdgcn_exp2f(Z.x), __builtin_amdgcn_exp2f(Z.y)}; Dn = Dn + 1.0f;
                        const f32x2 R = (f32x2){__builtin_amdgcn_rcpf(Dn.x), __builtin_amdgcn_rcpf(Dn.y)};
                        h[p] = (G * U) * (R * kk); }
                    u32x2 o8; o8.x = pk4_fp8(h[0].x, h[0].y, h[1].x, h[1].y); o8.y = pk4_fp8(h[2].x, h[2].y, h[3].x, h[3].y);
                    *(u32x2*)((unsigned char*)HID + (size_t)(u.pm * BM + r) * D + col0) = o8;
                }
            }
    }
};
struct EpiDown {
    bf16_t* Y; const int* LIST; float osc;
    __device__ __forceinline__ void operator()(const f32x4 (&acc)[2][2][4][2], const UnitG& u, int wr, int wc, int fr, int fq) const {
        const int col0 = u.pn * BM + wc * 32 + 8 * fq;
        int tk[2][4];
#pragma unroll
        for (int ai = 0; ai < 2; ++ai)
#pragma unroll
            for (int m = 0; m < 4; ++m) { const int r = ai * HALF + wr * 64 + m * 16 + fr; tk[ai][m] = LIST[u.x0 + (r < u.x1 ? r : 0)]; }
#pragma unroll
        for (int ai = 0; ai < 2; ++ai)
#pragma unroll
            for (int m = 0; m < 4; ++m) {
                const int r = ai * HALF + wr * 64 + m * 16 + fr;
                if (r < u.x1) {
                    const int tok = tk[ai][m]; bf16_t* rowp = Y + (size_t)tok * D + col0;
#pragma unroll
                    for (int bj = 0; bj < 2; ++bj) *(u32x4*)(rowp + bj * HALF) = pack8(acc[ai][bj][m][0], acc[ai][bj][m][1], osc);
                }
            }
    }
};
}

constexpr size_t MiB = 1u << 20;
constexpr size_t WS_CTL = 0, ZERO_BYTES = 1 * MiB;
constexpr size_t WS_CS = 2 * MiB;
constexpr size_t WS_WQKV = 18 * MiB, WS_WSO = 30 * MiB, WS_WRI = 34 * MiB, WS_WRO = 58 * MiB;
constexpr size_t WS_WGU = 66 * MiB, WS_WD = 98 * MiB;
constexpr size_t WS_XN = 114 * MiB;
constexpr size_t WS_PROJ = 178 * MiB;
constexpr size_t WS_LIST = 562 * MiB, WS_WTS = 565 * MiB, WS_XB = 577 * MiB, WS_XN8 = 641 * MiB, WS_ADAP = 673 * MiB, WS_ADA = 685 * MiB, WS_RWB = 686 * MiB, WS_END = 687 * MiB;
constexpr size_t PJ_Q = 0, PJ_K = 64 * MiB, PJ_V = 128 * MiB;
constexpr size_t PJ_RQ = 0, PJ_RK = 64 * MiB, PJ_RV = 128 * MiB, PJ_RG = 256 * MiB;
constexpr size_t PJ_HID = 0, PJ_Y2 = 128 * MiB;
constexpr int CW_BAR = 4096, CW_GCNT = 16384;
constexpr int RING_BYTES = 131072, LDSCTL_OFF = RING_BYTES, TBL_OFF = RING_BYTES + 1024, LDS_BYTES = 149504;
constexpr int RST_OFF = 36864, RST_ROW = 2064, RST_WAVE = 4 * RST_ROW;
constexpr int MAXU = 6;

#define XB_TMO      128
#define XB_XCNT(j)  (256  + 64 * (j))
#define XB_XSUB(j)  (1280 + 64 * (j))
#define XB_XGEN(j)  (2304 + 64 * (j))
#define XB_TOP      3328
#define XB_TOPGEN   3392
#define XCD_BAR_WORDS 3456
#define XB_SPIN_CAP (1u << 18)
__device__ __forceinline__ unsigned xb_ld(unsigned* p)              { return __hip_atomic_load(p, __ATOMIC_RELAXED, __HIP_MEMORY_SCOPE_AGENT); }
__device__ __forceinline__ unsigned xb_add(unsigned* p, unsigned v) { return __hip_atomic_fetch_add(p, v, __ATOMIC_RELAXED, __HIP_MEMORY_SCOPE_AGENT); }
__device__ __forceinline__ unsigned xb_xcc_id() { return (unsigned)__builtin_amdgcn_s_getreg((3 << 11) | 20) & 0xFu; }
#define XB_SPIN(cond, bar) do { unsigned _sp = 0; while (cond) { __builtin_amdgcn_s_sleep(1); \
    if ((++_sp & 255u) == 0u) { if (xb_ld(&(bar)[XB_TMO])) break; if (_sp > XB_SPIN_CAP) { atomicAdd(&(bar)[XB_TMO], 1u); break; } } } } while (0)
struct XcdBarrier { unsigned* bar; unsigned x; volatile LAS unsigned* st; };
__device__ __forceinline__ XcdBarrier xcd_barrier_post(unsigned* bar, volatile LAS unsigned* st) {
    XcdBarrier b; b.bar = bar; b.x = xb_xcc_id(); b.st = st;
    if (threadIdx.x == 0) (void)xb_add(&bar[XB_XCNT(b.x)], 1u);
    return b;
}
__device__ __forceinline__ void xcd_barrier_complete(unsigned* bar, unsigned x, unsigned& nloc, unsigned& nx) {
    const unsigned G = gridDim.x * gridDim.y * gridDim.z;
    unsigned sum, cnt, mine, sp = 0u;
    for (;;) {
        sum = 0u; cnt = 0u; mine = 0u;
#pragma unroll
        for (unsigned j = 0; j < 16; ++j) { const unsigned c = xb_ld(&bar[XB_XCNT(j)]); sum += c; cnt += (c > 0u) ? 1u : 0u; mine = (j == x) ? c : mine; }
        if (sum == G) break;
        __builtin_amdgcn_s_sleep(1);
        if ((++sp & 255u) == 0u) { if (xb_ld(&bar[XB_TMO])) break; if (sp > XB_SPIN_CAP) { atomicAdd(&bar[XB_TMO], 1u); break; } }
    }
    nloc = mine > 0u ? mine : 1u; nx = cnt > 0u ? cnt : 1u;
}
__device__ __forceinline__ void xcd_barrier(const XcdBarrier& b) {
    asm volatile("s_waitcnt vmcnt(0)" ::: "memory");
    __syncthreads();
    if (threadIdx.x == 0) {
        unsigned* bar = b.bar;
        __builtin_amdgcn_s_waitcnt(0);
        unsigned nloc = b.st[0], nx = b.st[1];
        if (nloc == 0u) { xcd_barrier_complete(bar, b.x, nloc, nx); b.st[0] = nloc; b.st[1] = nx; }
        const unsigned old = xb_add(&bar[XB_XSUB(b.x)], 1u);
        const unsigned gen = old / nloc;
        if (old + 1u == (gen + 1u) * nloc) {
            __builtin_amdgcn_fence(__ATOMIC_RELEASE, "agent");
            asm volatile("s_waitcnt vmcnt(0)" ::: "memory");
            const unsigned og = xb_add(&bar[XB_TOP], 1u);
            const unsigned tg = og / nx;
            if (og + 1u == (tg + 1u) * nx) xb_add(&bar[XB_TOPGEN], 1u);
            else XB_SPIN(xb_ld(&bar[XB_TOPGEN]) == tg, bar);
            __builtin_amdgcn_fence(__ATOMIC_ACQUIRE, "agent");
            xb_add(&bar[XB_XGEN(b.x)], 1u);
            asm volatile("s_waitcnt vmcnt(0)" ::: "memory");
        } else {
            XB_SPIN(xb_ld(&bar[XB_XGEN(b.x)]) == gen, bar);
            __builtin_amdgcn_fence(__ATOMIC_ACQUIRE, "agent");
            asm volatile("s_waitcnt vmcnt(0)" ::: "memory");
        }
    }
    __syncthreads();
}

typedef const __attribute__((address_space(4))) unsigned long long* kptr_t;
__device__ __forceinline__ const void* kin(int k) { kptr_t p = (kptr_t)__builtin_amdgcn_kernarg_segment_ptr(); asm volatile("" : "+s"(p)); return (const void*)(const GAS char*)p[k]; }
struct Frame {
    LAS unsigned char* lds; unsigned char* ws; unsigned* ctl;
    int tid, lane, wave, wave0, vcu, G, bx;
    float* out;
};
#define DPPADD(v, ctrl, rm) ((v) + __int_as_float(__builtin_amdgcn_update_dpp(0, __float_as_int(v), (ctrl), (rm), 0xf, false)))
__device__ __forceinline__ float row_total(float v) { v = DPPADD(v, 0xB1, 0xf); v = DPPADD(v, 0x4E, 0xf); v = DPPADD(v, 0x141, 0xf); v = DPPADD(v, 0x140, 0xf); return v; }
__device__ __forceinline__ float wave_total(float v) { v = row_total(v); v = DPPADD(v, 0x142, 0xa); v = DPPADD(v, 0x143, 0xc); return __int_as_float(__builtin_amdgcn_readlane(__float_as_int(v), 63)); }
__device__ __forceinline__ float shx(float v, int o, int lane) { return __int_as_float(__builtin_amdgcn_ds_bpermute((lane ^ o) << 2, __float_as_int(v))); }
__device__ __forceinline__ float wave_sum(float v, int lane) {
#pragma unroll
    for (int o = 1; o < 64; o <<= 1) v += shx(v, o, lane);
    return v;
}
__device__ __forceinline__ void tr_item(const float* Wsrc, int ldw, bf16_t* dst, int ldd, LAS float* scr, int lane) {
    f32x4 w[8];
#pragma unroll
    for (int r = 0; r < 8; ++r) { const int idx = r * 64 + lane; w[r] = *(const f32x4*)(Wsrc + (size_t)(idx >> 3) * ldw + 4 * (idx & 7)); }
#pragma unroll
    for (int r = 0; r < 8; ++r) { const int idx = r * 64 + lane; LAS float* d = scr + (idx >> 3) * 33 + 4 * (idx & 7); d[0] = w[r][0]; d[1] = w[r][1]; d[2] = w[r][2]; d[3] = w[r][3]; }
    LDS_WAIT(); asm volatile("" ::: "memory");
    const int c = lane & 7;
#pragma unroll
    for (int j = 0; j < 4; ++j) { const int n = (lane >> 3) + 8 * j; const LAS float* s = scr + (8 * c) * 33 + n;
        u32x4 o; o.x = cvtpk(s[0 * 33], s[1 * 33]); o.y = cvtpk(s[2 * 33], s[3 * 33]); o.z = cvtpk(s[4 * 33], s[5 * 33]); o.w = cvtpk(s[6 * 33], s[7 * 33]);
        *(GAS u32x4*)(dst + (size_t)n * ldd + 8 * c) = o; }
    LDS_WAIT(); asm volatile("" ::: "memory");
}
__device__ __forceinline__ void tr_item8(const float* Wsrc, int ldw, unsigned char* dst, int ldd, float scale, LAS float* scr, int lane) {
    f32x4 w[8];
#pragma unroll
    for (int r = 0; r < 8; ++r) { const int idx = r * 64 + lane; w[r] = *(const f32x4*)(Wsrc + (size_t)(idx >> 3) * ldw + 4 * (idx & 7)); }
#pragma unroll
    for (int r = 0; r < 8; ++r) { const int idx = r * 64 + lane; LAS float* d = scr + (idx >> 3) * 33 + 4 * (idx & 7); d[0] = w[r][0]; d[1] = w[r][1]; d[2] = w[r][2]; d[3] = w[r][3]; }
    LDS_WAIT(); asm volatile("" ::: "memory");
    const int c = lane & 7;
#pragma unroll
    for (int j = 0; j < 4; ++j) { const int n = (lane >> 3) + 8 * j; const LAS float* s = scr + (8 * c) * 33 + n;
        u32x2 o; o.x = pk4_fp8(s[0 * 33] * scale, s[1 * 33] * scale, s[2 * 33] * scale, s[3 * 33] * scale); o.y = pk4_fp8(s[4 * 33] * scale, s[5 * 33] * scale, s[6 * 33] * scale, s[7 * 33] * scale);
        *(GAS u32x2*)(dst + (size_t)n * ldd + 8 * c) = o; }
    LDS_WAIT(); asm volatile("" ::: "memory");
}
__device__ __forceinline__ void mixer_weight_item(Frame& F, int it, LAS float* scr) {
    const int half = it / 6144; int r = it % 6144; const int l = half;
    if (r < 1536) { const int kb = r / 96, nb = r % 96;
        tr_item(((const float*)kin(7)) + (size_t)l * 1024 * 3072 + (size_t)kb * 64 * 3072 + nb * 32, 3072, (bf16_t*)(F.ws + WS_WQKV) + (size_t)l * 3072 * 1024 + (size_t)nb * 32 * 1024 + kb * 64, 1024, scr, F.lane); return; }
    r -= 1536;
    if (r < 512) { const int kb = r / 32, nb = r % 32;
        tr_item8(((const float*)kin(8)) + (size_t)l * 1024 * 1024 + (size_t)kb * 64 * 1024 + nb * 32, 1024, (unsigned char*)(F.ws + WS_WSO) + (size_t)l * 2 * MiB + (size_t)nb * 32 * 1024 + kb * 64, 1024, 64.0f, scr, F.lane); return; }
    r -= 512;
    if (r < 3072) { const int kb = r / 192, nb = r % 192; const int s = nb * 32;
        int drow = s;
        if (s < 2048) { const int seg = s >> 10, head = (s >> 7) & 7, x2 = (s >> 6) & 1, j = s & 63; drow = (seg * 4 + (head >> 1)) * 256 + (x2 * 2 + (head & 1)) * 64 + j; }
        tr_item(((const float*)kin(9)) + (size_t)l * 1024 * 6144 + (size_t)kb * 64 * 6144 + s, 6144, (bf16_t*)(F.ws + WS_WRI) + (size_t)l * 6144 * 1024 + (size_t)drow * 1024 + kb * 64, 1024, scr, F.lane); return; }
    r -= 3072;
    { const int kb = r / 32, nb = r % 32;
        tr_item8(((const float*)kin(11)) + (size_t)l * 2048 * 1024 + (size_t)kb * 64 * 1024 + nb * 32, 1024, (unsigned char*)(F.ws + WS_WRO) + (size_t)l * 2 * MiB + (size_t)nb * 32 * 2048 + kb * 64, 2048, 64.0f, scr, F.lane); }
}
__device__ __forceinline__ void moe_weight_item(Frame& F, int layer, int it, LAS float* scr) {
    const int kind = it / 4096, r = it % 4096, e = r / 256, q = r % 256;
    if (kind < 2) { const int kb = q / 16, nb = q % 16, f = nb * 32; const int drow = (f >> 7) * 256 + kind * 128 + (f & 127);
        const float* W = (kind == 0 ? ((const float*)kin(14)) : ((const float*)kin(15))) + ((size_t)(layer * 16 + e) * 1024 + (size_t)kb * 64) * 512 + f;
        tr_item8(W, 512, (unsigned char*)(F.ws + WS_WGU) + ((size_t)e * 1024 + drow) * 1024 + kb * 64, 1024, 64.0f, scr, F.lane);
    } else { const int kb = q / 32, nb = q % 32;
        const float* W = ((const float*)kin(16)) + ((size_t)(layer * 16 + e) * 512 + (size_t)kb * 64) * 1024 + nb * 32;
        tr_item8(W, 1024, (unsigned char*)(F.ws + WS_WD) + ((size_t)(e >> 2) * 1024 + nb * 32) * 2048 + (e & 3) * 512 + kb * 64, 2048, 64.0f, scr, F.lane); }
}
__device__ __forceinline__ void moe_weight_phase(Frame& F, int layer, int it0, int it1, int rank, int nwk) {
    __syncthreads();
    LAS float* scr = (LAS float*)(F.lds + F.wave * 8448);
    for (int it = it0 + rank * 8 + F.wave; it < it1; it += nwk * 8) moe_weight_item(F, layer, it, scr);
}

__device__ __forceinline__ void p0_prologue(Frame& F) {
    LAS float* sc = (LAS float*)F.lds;
    for (int i = F.tid; i < 8 * 1024; i += 512) { const float v = ((const float*)kin(1))[i]; sc[i] = v / (1.0f + __expf(-v)); }
    __syncthreads();
    const int gw = F.vcu * 8 + F.wave, NGW = F.G * 8;
    float* ADAP = (float*)(F.ws + WS_ADAP);
    for (int it = gw; it < 8 * 12 * 16; it += NGW) {
        const int ks = it & 15, cg = (it >> 4) % 12, j = it / 192;
        const float* W = ((const float*)kin(3)) + ((size_t)j * 1024 + ks * 64) * 3072 + cg * 256 + 4 * F.lane;
        f32x4 a[8];
#pragma unroll
        for (int b = 0; b < 8; ++b) a[b] = (f32x4){0.f, 0.f, 0.f, 0.f};
#pragma unroll 1
        for (int k0 = 0; k0 < 64; k0 += 8) {
            f32x4 w[8];
#pragma unroll
            for (int u = 0; u < 8; ++u) w[u] = *(const f32x4*)(W + (size_t)(k0 + u) * 3072);
#pragma unroll
            for (int u = 0; u < 8; ++u)
#pragma unroll
                for (int b = 0; b < 8; ++b) a[b] = a[b] + w[u] * sc[b * 1024 + ks * 64 + k0 + u];
        }
#pragma unroll
        for (int b = 0; b < 8; ++b) *(f32x4*)(ADAP + ((size_t)(ks * 8 + j) * 8 + b) * 3072 + cg * 256 + 4 * F.lane) = a[b];
    }
    if (F.vcu == 0) { const float* rw = (const float*)kin(12); bf16_t* RWB = (bf16_t*)(F.ws + WS_RWB);
        for (int i = F.tid; i < 16 * 1032; i += 512) { const int e = i / 1032, d = i % 1032; RWB[i] = (d < 1024) ? (bf16_t)(cvtpk(rw[d * 16 + e], 0.f) & 0xffffu) : (bf16_t)0; } }
    LAS float* scr = (LAS float*)(F.lds + 32768 + F.wave * 8448);
    for (int it = gw; it < 6144; it += NGW) mixer_weight_item(F, it, scr);
}
__device__ __forceinline__ void late_prologue(Frame& F, int rank, int nwk) {
    __syncthreads();
    const int gw = rank * 8 + F.wave, NGW = nwk * 8;
    LAS float* scr = (LAS float*)(F.lds + 32768 + F.wave * 8448);
    for (int it = 6144 + gw; it < 12288; it += NGW) mixer_weight_item(F, it, scr);
    f32x2* CS = (f32x2*)(F.ws + WS_CS);
    const float invf = 1.0f / __powf(10000.0f, (float)(2 * F.lane) * (1.0f / 128.0f));
    const int* posp = (const int*)kin(2);
    for (int row0_ = gw; row0_ < T; row0_ += 16 * NGW) {
      int pos16[16];
#pragma unroll
      for (int k = 0; k < 16; ++k) { const int rr = row0_ + k * NGW; pos16[k] = (rr < T) ? posp[rr] : 0; }
#pragma unroll
      for (int k = 0; k < 16; ++k) { const int row = row0_ + k * NGW; if (row < T) {
        const float ang = (float)pos16[k] * invf;
        const double rev = (double)ang * 0.15915494309189535; const float fr = (float)(rev - floor(rev));
        CS[(size_t)row * 64 + F.lane] = (f32x2){__builtin_amdgcn_cosf(fr), __builtin_amdgcn_sinf(fr)};
      } }
    }
}
__device__ __forceinline__ f32x4 mod_piece(Frame& F, size_t idx  , const float* bias, int which) {
    const float* P = (const float*)(F.ws + WS_ADAP) + idx; f32x4 a[8];
#pragma unroll
    for (int ks = 0; ks < 8; ++ks) a[ks] = *(const f32x4*)(P + (size_t)ks * 64 * 3072);
    asm volatile("" ::: "memory");
#pragma unroll
    for (int ks = 0; ks < 8; ++ks) a[ks] = a[ks] + *(const f32x4*)(P + (size_t)(8 + ks) * 64 * 3072);
#pragma unroll
    for (int st = 4; st >= 1; st >>= 1)
#pragma unroll
        for (int k = 0; k < st; ++k) a[k] = a[k] + a[k + st];
    const f32x4 r = a[0] + *(const f32x4*)bias + (which ? 1.0f : 0.0f);
    asm volatile("" ::: "memory");
    return r;
}
__device__ __forceinline__ void load_mod(Frame& F, int j, int b, int which, f32x4 (&v)[4]) {
    const float* A = (const float*)(F.ws + WS_ADA) + (size_t)(j * 8 + b) * 3072 + which * 1024;
#pragma unroll
    for (int q = 0; q < 4; ++q) v[q] = *(const f32x4*)(A + 512 * (q >> 1) + 8 * F.lane + 4 * (q & 1));
}
__device__ __forceinline__ void p1_mod0(Frame& F) {
    const int row0 = F.vcu * (T / F.G), b = row0 / SEQ; bf16_t* XN = (bf16_t*)(F.ws + WS_XN); bf16_t* XB = (bf16_t*)(F.ws + WS_XB);
    LAS f32x4* m0 = (LAS f32x4*)F.lds;
    { const int col = 4 * F.tid; m0[F.tid] = mod_piece(F, (size_t)b * 3072 + col, (const float*)kin(4) + col, col >= 1024 ? 1 : 0); }
    __syncthreads();
    f32x4 sh[4], sc[4];
#pragma unroll
    for (int jj = 0; jj < 4; ++jj) { sh[jj] = m0[64 * jj + F.lane]; sc[jj] = m0[256 + 64 * jj + F.lane]; }
    {
        float* A = (float*)(F.ws + WS_ADA); const float* bias = (const float*)kin(4);
        for (int p4 = F.vcu * 512 + F.tid; p4 < 8 * 8 * 3072 / 4; p4 += F.G * 512) { const int idx = 4 * p4, jb = idx / 3072, col = idx % 3072;
            *(f32x4*)(A + idx) = mod_piece(F, (size_t)idx, bias + (size_t)(jb >> 3) * 3072 + col, col >= 1024 ? 1 : 0); } }
    const float* xin = (const float*)kin(0);
    for (int r = F.wave; r < T / F.G; r += 32) {
        f32x4 xv[4][4];
#pragma unroll
        for (int q = 0; q < 4; ++q)
#pragma unroll
            for (int jj = 0; jj < 4; ++jj) { const int rr = r + 8 * q; xv[q][jj] = (rr < T / F.G) ? *(const f32x4*)(xin + (size_t)(row0 + rr) * D + 256 * jj + 4 * F.lane) : (f32x4){0.f, 0.f, 0.f, 0.f}; }
#pragma unroll
        for (int q = 0; q < 4; ++q) { const int rr = r + 8 * q; if (rr < T / F.G) { const size_t row = row0 + rr;
#pragma unroll
            for (int jj = 0; jj < 4; ++jj) { const f32x4 h = xv[q][jj] * sc[jj] + sh[jj];
                u32x2 w; w.x = cvtpk(h[0], h[1]); w.y = cvtpk(h[2], h[3]); *(u32x2*)(XN + row * D + 256 * jj + 4 * F.lane) = w;
                u32x2 wx; wx.x = cvtpk(xv[q][jj][0], xv[q][jj][1]); wx.y = cvtpk(xv[q][jj][2], xv[q][jj][3]); *(u32x2*)(XB + row * D + 256 * jj + 4 * F.lane) = wx; } } }
    }
}

__device__ __forceinline__ void ln_phase(Frame& F, const bf16_t* Y, int j, int jn, bool router, int layer) {
    bf16_t* XB = (bf16_t*)(F.ws + WS_XB); const bool final_out = (jn < 0); unsigned char* XN8 = F.ws + WS_XN8;
    const int RPW = T / F.G;
    const int row0 = F.vcu * RPW, b = row0 / SEQ; bf16_t* XNp = (bf16_t*)(F.ws + WS_XN);
    LAS bf16_t* rwb = (LAS bf16_t*)F.lds;
    LAS int* lhist = (LAS int*)(F.lds + 33280); LAS int* gbase = lhist + 32; LAS int* rinfo = lhist + 64;
    if (router) {
        const u32x4* src = (const u32x4*)(F.ws + WS_RWB); LAS u32x4* dst = (LAS u32x4*)rwb;
        for (int i = F.tid; i < 16 * 1032 * 2 / 16; i += 512) dst[i] = src[i];
        if (F.tid < 32) lhist[F.tid] = 0;
    }
    __syncthreads();
    f32x4 gt[4], lg[4], lb[4], sh[4], sc[4];
    load_mod(F, j, b, 2, gt);
    { const float* lng = (const float*)kin(5) + (size_t)j * 1024; const float* lnb = (const float*)kin(6) + (size_t)j * 1024;
#pragma unroll
      for (int q = 0; q < 4; ++q) { const int co = 512 * (q >> 1) + 8 * F.lane + 4 * (q & 1); lg[q] = *(const f32x4*)(lng + co); lb[q] = *(const f32x4*)(lnb + co); } }
    if (jn >= 0) { load_mod(F, jn, b, 0, sh); load_mod(F, jn, b, 1, sc); }
    u32x4 xv[2], xn[2], xm[2], yw[2], yn[2], ym[2];
#define LN_LOAD(XBUF, YB, rr) do { const size_t row_ = (size_t)(rr); _Pragma("unroll") for (int jj = 0; jj < 2; ++jj) { XBUF[jj] = __builtin_nontemporal_load((const u32x4*)(XB + row_ * D + 512 * jj + 8 * F.lane)); YB[jj] = __builtin_nontemporal_load((const u32x4*)(Y + row_ * D + 512 * jj + 8 * F.lane)); } } while (0)
    LN_LOAD(xn, yn, row0 + F.wave);
    if (F.wave + 8 < RPW) LN_LOAD(xm, ym, row0 + F.wave + 8);
    for (int r = F.wave; r < RPW; r += 8) {
        const size_t row = row0 + r;
#pragma unroll
        for (int jj = 0; jj < 2; ++jj) { xv[jj] = xn[jj]; yw[jj] = yn[jj]; xn[jj] = xm[jj]; yn[jj] = ym[jj]; }
        if (r + 16 < RPW) LN_LOAD(xm, ym, row + 16);
        f32x4 v[4]; float s = 0.f, s2 = 0.f;
#pragma unroll
        for (int jj = 0; jj < 2; ++jj) {
            const f32x4 y0 = {bflo(yw[jj].x), bfhi(yw[jj].x), bflo(yw[jj].y), bfhi(yw[jj].y)}, y1 = {bflo(yw[jj].z), bfhi(yw[jj].z), bflo(yw[jj].w), bfhi(yw[jj].w)};
            const f32x4 x0 = {bflo(xv[jj].x), bfhi(xv[jj].x), bflo(xv[jj].y), bfhi(xv[jj].y)}, x1 = {bflo(xv[jj].z), bfhi(xv[jj].z), bflo(xv[jj].w), bfhi(xv[jj].w)};
            v[2 * jj] = x0 * DN_ALPHA + gt[2 * jj] * y0; v[2 * jj + 1] = x1 * DN_ALPHA + gt[2 * jj + 1] * y1; }
#pragma unroll
        for (int q = 0; q < 4; ++q) s += (v[q][0] + v[q][1]) + (v[q][2] + v[q][3]);
        const float mean = wave_total(s) * (1.f / D);
#pragma unroll
        for (int q = 0; q < 4; ++q) { v[q] = v[q] - mean; s2 += (v[q][0] * v[q][0] + v[q][1] * v[q][1]) + (v[q][2] * v[q][2] + v[q][3] * v[q][3]); }
        const float rstd = 1.f / sqrtf(wave_total(s2) * (1.f / D) + LN_EPS);
#pragma unroll
        for (int q = 0; q < 4; ++q) v[q] = v[q] * rstd * lg[q] + lb[q];
#pragma unroll
        for (int jj = 0; jj < 2; ++jj) {
            if (final_out) { *(f32x4*)(F.out + row * D + 512 * jj + 8 * F.lane) = v[2 * jj]; *(f32x4*)(F.out + row * D + 512 * jj + 8 * F.lane + 4) = v[2 * jj + 1]; }
            else { u32x4 w; w.x = cvtpk(v[2 * jj][0], v[2 * jj][1]); w.y = cvtpk(v[2 * jj][2], v[2 * jj][3]); w.z = cvtpk(v[2 * jj + 1][0], v[2 * jj + 1][1]); w.w = cvtpk(v[2 * jj + 1][2], v[2 * jj + 1][3]);
                __builtin_nontemporal_store(w, (u32x4*)(XB + row * D + 512 * jj + 8 * F.lane)); } }
        if (jn >= 0) {
#pragma unroll
            for (int q = 0; q < 4; ++q) v[q] = v[q] * sc[q] + sh[q];
#pragma unroll
            for (int jj = 0; jj < 2; ++jj) { u32x4 w; w.x = cvtpk(v[2 * jj][0], v[2 * jj][1]); w.y = cvtpk(v[2 * jj][2], v[2 * jj][3]); w.z = cvtpk(v[2 * jj + 1][0], v[2 * jj + 1][1]); w.w = cvtpk(v[2 * jj + 1][2], v[2 * jj + 1][3]);
                if (!router) *(u32x4*)(XNp + row * D + 512 * jj + 8 * F.lane) = w;
                else *(LAS u32x4*)(F.lds + RST_OFF + F.wave * RST_WAVE + ((r >> 3) & 3) * RST_ROW + 1024 * jj + 16 * F.lane) = w;
                if (router) { u32x2 w8; w8.x = pk4_fp8(v[2 * jj][0], v[2 * jj][1], v[2 * jj][2], v[2 * jj][3]); w8.y = pk4_fp8(v[2 * jj + 1][0], v[2 * jj + 1][1], v[2 * jj + 1][2], v[2 * jj + 1][3]);
                    *(u32x2*)(XN8 + row * D + 512 * jj + 8 * F.lane) = w8; } }
        }
        if (router && ((r >> 3) & 3) == 3) {
            asm volatile("" ::: "memory");
            const int t = F.lane & 15, g = F.lane >> 4; const int rloc = (r - 24) + 8 * (t & 3);
            LAS const unsigned char* hrow = F.lds + RST_OFF + F.wave * RST_WAVE + (t & 3) * RST_ROW + 16 * g;
            f32x4 acc = {0.f, 0.f, 0.f, 0.f};
#pragma unroll
            for (int kk = 0; kk < 32; ++kk) { const bf16x8 hb_ = *(const LAS bf16x8*)(hrow + 64 * kk); const bf16x8 wa_ = *(const LAS bf16x8*)(rwb + (F.lane & 15) * 1032 + 32 * kk + 8 * g); acc = __builtin_amdgcn_mfma_f32_16x16x32_bf16(wa_, hb_, acc, 0, 0, 0); }
            const f32x4 rb4 = *(const f32x4*)((const float*)kin(13) + 4 * g);
            float l4[4] = {acc[0] + rb4[0], acc[1] + rb4[1], acc[2] + rb4[2], acc[3] + rb4[3]};
            float mx = fmaxf(fmaxf(l4[0], l4[1]), fmaxf(l4[2], l4[3]));
            mx = fmaxf(mx, shx(mx, 16, F.lane)); mx = fmaxf(mx, shx(mx, 32, F.lane));
            int i1 = 0; float v1 = l4[0];
#pragma unroll
            for (int i = 1; i < 4; ++i) if (l4[i] > v1) { v1 = l4[i]; i1 = i; }
            int i2 = -1; float v2 = -INFINITY;
#pragma unroll
            for (int i = 0; i < 4; ++i) if (i != i1 && (i2 < 0 || l4[i] > v2)) { v2 = l4[i]; i2 = i; }
            float bsc = __expf(v1 - mx) + __expf(v2 - mx); int bg = g;
            { const float os = shx(bsc, 16, F.lane); const int og = __builtin_amdgcn_ds_bpermute((F.lane ^ 16) << 2, bg); if (os > bsc || (os == bsc && og < bg)) { bsc = os; bg = og; } }
            { const float os = shx(bsc, 32, F.lane); const int og = __builtin_amdgcn_ds_bpermute((F.lane ^ 32) << 2, bg); if (os > bsc || (os == bsc && og < bg)) { bsc = os; bg = og; } }
            if (bg == g && t < 4) {
                const float w1 = 1.0f / (1.0f + __expf(v2 - v1)), w2 = 1.0f - w1;
                const int la = i1 < i2 ? i1 : i2, lbx = i1 < i2 ? i2 : i1; const float wa = i1 < i2 ? w1 : w2, wb = i1 < i2 ? w2 : w1;
                const int pair = (la == 0) ? (lbx - 1) : (la == 1 ? lbx + 1 : 5);
                const int bucket = g * 6 + pair;
                const int rank = __hip_atomic_fetch_add(lhist + bucket, 1, __ATOMIC_RELAXED, __HIP_MEMORY_SCOPE_WORKGROUP);
                rinfo[rloc * 4 + 0] = bucket; rinfo[rloc * 4 + 1] = rank; rinfo[rloc * 4 + 2] = __float_as_int(wa); rinfo[rloc * 4 + 3] = __float_as_int(wb);
            }
        }
    }
    if (router) {
        __syncthreads();
        unsigned* gcnt = F.ctl + CW_GCNT + layer * 64;
        if (F.tid < NBUCKET) gbase[F.tid] = (int)__hip_atomic_fetch_add(gcnt + F.tid, (unsigned)lhist[F.tid], __ATOMIC_RELAXED, __HIP_MEMORY_SCOPE_AGENT);
        __syncthreads();
        int* LIST = (int*)(F.ws + WS_LIST); f32x2* WTS = (f32x2*)(F.ws + WS_WTS);
        for (int r = F.tid; r < RPW; r += 512) { const int bucket = rinfo[r * 4 + 0], pos = gbase[bucket] + rinfo[r * 4 + 1];
            LIST[(size_t)bucket * T + pos] = row0 + r; WTS[(size_t)bucket * T + pos] = (f32x2){__int_as_float(rinfo[r * 4 + 2]), __int_as_float(rinfo[r * 4 + 3])}; }
    }
#undef LN_LOAD
}

__device__ __forceinline__ void gate_phase(Frame& F, int rl) {
    const bf16_t* RV = (const bf16_t*)(F.ws + WS_PROJ + PJ_RV); const bf16_t* RG = (const bf16_t*)(F.ws + WS_PROJ + PJ_RG); unsigned char* A8 = F.ws + WS_PROJ + PJ_RK;
    const float* gn = ((const float*)kin(10)) + (size_t)rl * 2048;
    const int gw = F.vcu * 8 + F.wave, NGW = F.G * 8;
    u32x4 ow[4], gv[4], on[4], gnx[4];
    f32x4 gnv[4][2];
#pragma unroll
    for (int jj = 0; jj < 4; ++jj) { gnv[jj][0] = *(const f32x4*)(gn + jj * 512 + F.lane * 8); gnv[jj][1] = *(const f32x4*)(gn + jj * 512 + F.lane * 8 + 4); }
#define GT_LOAD(OB, GB, rr) do { _Pragma("unroll") for (int jj = 0; jj < 4; ++jj) { const size_t off_ = (size_t)(rr) * 2048 + jj * 512 + F.lane * 8; OB[jj] = __builtin_nontemporal_load((const u32x4*)(RV + off_)); GB[jj] = __builtin_nontemporal_load((const u32x4*)(RG + off_)); } } while (0)
    if (gw < T) GT_LOAD(on, gnx, gw);
    for (int row = gw; row < T; row += NGW) {
#pragma unroll
        for (int jj = 0; jj < 4; ++jj) { ow[jj] = on[jj]; gv[jj] = gnx[jj]; }
        if (row + NGW < T) GT_LOAD(on, gnx, row + NGW);
#pragma unroll
        for (int jj = 0; jj < 4; ++jj) {
            const size_t off = (size_t)row * 2048 + jj * 512 + F.lane * 8;
            const u32x4 o4 = ow[jj], gw4 = gv[jj];
            float o[8] = {bflo(o4.x), bfhi(o4.x), bflo(o4.y), bfhi(o4.y), bflo(o4.z), bfhi(o4.z), bflo(o4.w), bfhi(o4.w)};
            const float g[8] = {bflo(gw4.x), bfhi(gw4.x), bflo(gw4.y), bfhi(gw4.y), bflo(gw4.z), bfhi(gw4.z), bflo(gw4.w), bfhi(gw4.w)};
            float s = 0.f;
#pragma unroll
            for (int i = 0; i < 8; ++i) s += o[i];
            s = row_total(s); s += shx(s, 16, F.lane);
            const float mu = s * (1.f / 256.f); float q = 0.f;
#pragma unroll
            for (int i = 0; i < 8; ++i) { o[i] -= mu; q += o[i] * o[i]; }
            q = row_total(q); q += shx(q, 16, F.lane);
            const float rstd = 1.f / sqrtf(q * (1.f / 256.f) + LN_EPS);
            const f32x4 g0 = gnv[jj][0], g1 = gnv[jj][1];
            float r[8];
#pragma unroll
            for (int i = 0; i < 8; ++i) r[i] = o[i] * rstd * (i < 4 ? g0[i] : g1[i - 4]) * gp::silu_f(g[i]);
#pragma unroll
            for (int i = 0; i < 8; ++i) r[i] = __builtin_amdgcn_fmed3f(r[i] * 16.0f, -440.0f, 440.0f);
            u32x2 w8; w8.x = pk4_fp8(r[0], r[1], r[2], r[3]); w8.y = pk4_fp8(r[4], r[5], r[6], r[7]);
            *(u32x2*)(A8 + (size_t)row * 2048 + jj * 512 + F.lane * 8) = w8;
        }
    }
#undef GT_LOAD
}

namespace sb {
constexpr int SLOTB = 8192, NSLOT = 3, L_K = 0, L_V = NSLOT * SLOTB, L_FLAG = 2 * NSLOT * SLOTB, L_OST = L_FLAG + 256;
__device__ __forceinline__ int crow(int r, int hi) { return (r & 3) + 8 * (r >> 2) + 4 * hi; }
__device__ __forceinline__ float fadd_s(float a, float b) { float r; asm("v_add_f32_e32 %0, %1, %2" : "=v"(r) : "v"(a), "v"(b)); return r; }
#define SB_WAIT_BAR(N) asm volatile("s_waitcnt vmcnt(" #N ") lgkmcnt(0)\n\ts_barrier" ::: "memory")
__device__ __forceinline__ void unit(int tid, int b, int h, int qb, const bf16_t* Q, const bf16_t* K, const bf16_t* V, unsigned char* O8, LAS unsigned char* lds, const bool pre, const int nxb, const int nxh, const int nxqb, unsigned long long& tacc, const int pcls) {
    const int lane = tid & 63, r32 = lane & 31, hi = lane >> 5; const int wid = __builtin_amdgcn_readfirstlane(tid >> 6);
    const long rowbase = (long)b * SEQ; const int q0 = qb * 256;
    const bf16_t* Qw = Q + (rowbase + q0 + wid * 32) * D + h * 64;
    const bf16_t* Kh = K + rowbase * D + h * 64; const bf16_t* Vh = V + rowbase * D + h * 64;
    const int kkey = 8 * wid + (lane >> 3);
    const bf16_t* ksrc = Kh + (long)kkey * D + (((lane & 7) ^ ((kkey >> 1) & 7)) * 8);
    const bf16_t* vsrc = Vh + (long)(16 * (wid & 3) + (lane >> 2)) * D + (wid >> 2) * 32 + (lane & 3) * 8;
#define SB_DMA(t, slot) do { \
        __builtin_amdgcn_global_load_lds((const unsigned*)(ksrc + (long)(t) * 64 * D), (LAS unsigned*)(lds + L_K + (slot) * SLOTB + wid * 1024), 16, 0, 0); \
        __builtin_amdgcn_global_load_lds((const unsigned*)(vsrc + (long)(t) * 64 * D), (LAS unsigned*)(lds + L_V + (slot) * SLOTB + wid * 1024), 16, 0, 0); } while (0)
    const int t0 = 4 * qb + 3;
    if (!pre) { SB_DMA(t0, 0); SB_DMA(t0 - 1, 1); }
    bf16x8 qr[4];
#pragma unroll
    for (int d0 = 0; d0 < 4; ++d0) qr[d0] = *(const bf16x8*)(Qw + (long)r32 * D + d0 * 16 + hi * 8);
    f32x16 o0 = {}, o1 = {}; float carry = 0.f; int wdone = 0;
    const int qlo = q0 + 32 * wid, qme = qlo + r32;
    LAS int* flags = (LAS int*)(lds + L_FLAG);
    const LAS unsigned char* kp0 = lds + L_K + r32 * 128 + 16 * (hi ^ ((r32 >> 1) & 7));
    const unsigned vb0 = (unsigned)(size_t)(lds + L_V) + ((lane >> 4) & 1) * 32 + (lane & 3) * 8 + (4 * hi + ((lane & 15) >> 2)) * 64;
    int sl = 0;
    for (int j = t0; j >= 0; --j) {
        { const unsigned long long t0_ = pcls ? __builtin_amdgcn_s_memrealtime() : 0ull; if (j >= 1) SB_WAIT_BAR(2); else SB_WAIT_BAR(0); if (pcls == 20) tacc += __builtin_amdgcn_s_memrealtime() - t0_; }
        const unsigned long long t1_ = (pcls == 21) ? __builtin_amdgcn_s_memrealtime() : 0ull;
        if (j < t0) { const LAS int* fl = flags + ((j + 1) & 1) * 8; int all = 1;
#pragma unroll
            for (int w = 0; w < 8; ++w) all &= fl[w];
            if (__builtin_amdgcn_readfirstlane(all)) break; }
        { const int s2 = (sl >= 1) ? sl - 1 : 2; if (j >= 2) SB_DMA(j - 2, s2); }
        const int kmin = 64 * j;
        if (kmin < qlo + 31 && !wdone) {
            const unsigned kpo = (unsigned)(kp0 - lds) + sl * SLOTB;
            f32x16 p0 = {}, p1 = {};
#pragma unroll
            for (int d0 = 0; d0 < 4; ++d0) { const unsigned ko = kpo ^ ((unsigned)d0 << 5); const bf16x8 k0 = *(const LAS bf16x8*)(lds + ko), k1 = *(const LAS bf16x8*)(lds + ko + 4096);
                p0 = __builtin_amdgcn_mfma_f32_32x32x16_bf16(k0, qr[d0], p0, 0, 0, 0); p1 = __builtin_amdgcn_mfma_f32_32x32x16_bf16(k1, qr[d0], p1, 0, 0, 0); }
            f32x16 l0, l1;
            asm volatile("s_nop 15\n\ts_nop 7" : "+v"(p0), "+v"(p1));
#pragma unroll
            for (int r = 0; r < 16; ++r) { float za, zb; asm("v_min_f32_e32 %0, 0x42c80000, %1" : "=v"(za) : "v"(p0[r])); asm("v_min_f32_e32 %0, 0x42c80000, %1" : "=v"(zb) : "v"(p1[r])); p0[r] = za; p1[r] = zb;
                l0[r] = __builtin_amdgcn_logf(1.0f + __builtin_amdgcn_exp2f(za)); l1[r] = __builtin_amdgcn_logf(1.0f + __builtin_amdgcn_exp2f(zb)); }
            if (kmin + 63 >= qlo) {
#pragma unroll
                for (int r = 0; r < 16; ++r) { const int kv = kmin + crow(r, hi);
                    if (kv >= qme) { p0[r] = -INFINITY; l0[r] = 0.f; } if (kv + 32 >= qme) { p1[r] = -INFINITY; l1[r] = 0.f; } }
            }
            float bs[8], pm[8], tt[8];
#pragma unroll
            for (int g = 0; g < 4; ++g) { bs[g] = fadd_s(fadd_s(l0[4 * g], l0[4 * g + 1]), fadd_s(l0[4 * g + 2], l0[4 * g + 3])); bs[4 + g] = fadd_s(fadd_s(l1[4 * g], l1[4 * g + 1]), fadd_s(l1[4 * g + 2], l1[4 * g + 3])); }
#pragma unroll
            for (int g = 0; g < 8; ++g) { auto rr = __builtin_amdgcn_permlane32_swap(__float_as_uint(bs[g]), __float_as_uint(bs[g]), false, false);
                const float lo = __uint_as_float(rr[0]), up = __uint_as_float(rr[1]); tt[g] = fadd_s(lo, up); pm[g] = hi ? 0.f : up; }
            float sp = carry;
#pragma unroll
            for (int g = 7; g >= 0; --g) {
                const float base = sp + pm[g];
                if (g >= 4) { const int q = 4 * (g - 4); const float c3 = base + l1[q + 3], c2 = c3 + l1[q + 2], c1 = c2 + l1[q + 1], c0 = c1 + l1[q];
                    p1[q + 3] = __builtin_amdgcn_exp2f(p1[q + 3] - c3); p1[q + 2] = __builtin_amdgcn_exp2f(p1[q + 2] - c2); p1[q + 1] = __builtin_amdgcn_exp2f(p1[q + 1] - c1); p1[q] = __builtin_amdgcn_exp2f(p1[q] - c0);
                } else { const int q = 4 * g; const float c3 = base + l0[q + 3], c2 = c3 + l0[q + 2], c1 = c2 + l0[q + 1], c0 = c1 + l0[q];
                    p0[q + 3] = __builtin_amdgcn_exp2f(p0[q + 3] - c3); p0[q + 2] = __builtin_amdgcn_exp2f(p0[q + 2] - c2); p0[q + 1] = __builtin_amdgcn_exp2f(p0[q + 1] - c1); p0[q] = __builtin_amdgcn_exp2f(p0[q] - c0); }
                sp += tt[g];
            }
            carry = sp;
            u32x4 pw0, pw1, pw2, pw3;
            pw0 = (u32x4){cvtpk(p0[0], p0[1]), cvtpk(p0[2], p0[3]), cvtpk(p0[4], p0[5]), cvtpk(p0[6], p0[7])}; pw1 = (u32x4){cvtpk(p0[8], p0[9]), cvtpk(p0[10], p0[11]), cvtpk(p0[12], p0[13]), cvtpk(p0[14], p0[15])};
            pw2 = (u32x4){cvtpk(p1[0], p1[1]), cvtpk(p1[2], p1[3]), cvtpk(p1[4], p1[5]), cvtpk(p1[6], p1[7])}; pw3 = (u32x4){cvtpk(p1[8], p1[9]), cvtpk(p1[10], p1[11]), cvtpk(p1[12], p1[13]), cvtpk(p1[14], p1[15])};
            const unsigned vb = vb0 + sl * SLOTB;
#pragma unroll
            for (int d0 = 0; d0 < 2; ++d0) { s16x4 lo[4], up[4];
#pragma unroll
                for (int ks = 0; ks < 4; ++ks) {
                    asm volatile("ds_read_b64_tr_b16 %0,%1 offset:%c2" : "=&v"(lo[ks]) : "v"(vb), "i"(d0 * 4096 + ks * 1024) : "memory");
                    asm volatile("ds_read_b64_tr_b16 %0,%1 offset:%c2" : "=&v"(up[ks]) : "v"(vb), "i"(d0 * 4096 + ks * 1024 + 512) : "memory"); }
                asm volatile("s_waitcnt lgkmcnt(0)" : "+v"(lo[0]), "+v"(lo[1]), "+v"(lo[2]), "+v"(lo[3]), "+v"(up[0]), "+v"(up[1]), "+v"(up[2]), "+v"(up[3]) :: "memory"); SBAR();
#define SB_PK(k) (bf16x8){lo[k][0], lo[k][1], lo[k][2], lo[k][3], up[k][0], up[k][1], up[k][2], up[k][3]}
                f32x16 oo = d0 ? o1 : o0;
                oo = __builtin_amdgcn_mfma_f32_32x32x16_bf16(__builtin_bit_cast(bf16x8, pw0), SB_PK(0), oo, 0, 0, 0);
                oo = __builtin_amdgcn_mfma_f32_32x32x16_bf16(__builtin_bit_cast(bf16x8, pw1), SB_PK(1), oo, 0, 0, 0);
                oo = __builtin_amdgcn_mfma_f32_32x32x16_bf16(__builtin_bit_cast(bf16x8, pw2), SB_PK(2), oo, 0, 0, 0);
                oo = __builtin_amdgcn_mfma_f32_32x32x16_bf16(__builtin_bit_cast(bf16x8, pw3), SB_PK(3), oo, 0, 0, 0);
                if (d0) o1 = oo; else o0 = oo;
#undef SB_PK
            }
        }
        { const int done = __all(carry > -SB_EXIT) ? 1 : 0; wdone = done; if (lane == 0) flags[(j & 1) * 8 + wid] = done; }
        if (pcls == 21) tacc += __builtin_amdgcn_s_memrealtime() - t1_;
        sl = (sl == 2) ? 0 : sl + 1;
    }
    const unsigned long long t2_ = (pcls == 22) ? __builtin_amdgcn_s_memrealtime() : 0ull;
    asm volatile("s_waitcnt vmcnt(0) lgkmcnt(0)\n\ts_barrier" ::: "memory");
    if (nxqb >= 0) { const long nrb = (long)nxb * SEQ; const int nt0 = 4 * nxqb + 3;
        const bf16_t* nk = K + nrb * D + nxh * 64 + (long)kkey * D + (((lane & 7) ^ ((kkey >> 1) & 7)) * 8);
        const bf16_t* nv = V + nrb * D + nxh * 64 + (long)(16 * (wid & 3) + (lane >> 2)) * D + (wid >> 2) * 32 + (lane & 3) * 8;
#pragma unroll
        for (int q = 0; q < 2; ++q) {
            __builtin_amdgcn_global_load_lds((const unsigned*)(nk + (long)(nt0 - q) * 64 * D), (LAS unsigned*)(lds + L_K + q * SLOTB + wid * 1024), 16, 0, 0);
            __builtin_amdgcn_global_load_lds((const unsigned*)(nv + (long)(nt0 - q) * 64 * D), (LAS unsigned*)(lds + L_V + q * SLOTB + wid * 1024), 16, 0, 0); } }
    unsigned char* Ow = O8 + (rowbase + q0 + wid * 32) * D + h * 64;
    { LAS unsigned char* stg = lds + L_OST + wid * 4096;
#pragma unroll
        for (int r = 0; r < 16; ++r) { const int orow = crow(r, hi); const unsigned w = (unsigned)__builtin_amdgcn_cvt_pk_fp8_f32(o0[r] * 64.0f, o1[r] * 64.0f, 0, false);
            stg[orow * 64 + r32] = (unsigned char)(w & 0xffu); stg[orow * 64 + 32 + r32] = (unsigned char)((w >> 8) & 0xffu); }
        asm volatile("s_waitcnt lgkmcnt(0)" ::: "memory");
#pragma unroll
        for (int i = 0; i < 2; ++i) { const int row = i * 16 + (lane >> 2), ch = lane & 3; const u32x4 v = *(const LAS u32x4*)(stg + row * 64 + ch * 16); *(u32x4*)(Ow + (long)row * D + ch * 16) = v; } }
    asm volatile("s_waitcnt lgkmcnt(0)" ::: "memory");
    if (pcls == 22) tacc += __builtin_amdgcn_s_memrealtime() - t2_;
#undef SB_DMA
}
}

namespace ret {
constexpr int KV_BYTES = 49152, V_OFF = 32768, Q_OFF = 2 * KV_BYTES, ST_OFF = TBL_OFF;
__device__ __forceinline__ unsigned offb(unsigned row, unsigned ch) { return 256u * row + 16u * (ch ^ (((row & 3) << 2) | ((row >> 2) & 3))); }
__device__ __forceinline__ void unit(int tid, int b, int h, int sl, const bf16_t* RQ, const bf16_t* RK, bf16_t* RV, LAS unsigned char* lds, unsigned long long& tacc, const int pcls) {
    const int lane = tid & 63, r32 = lane & 31, hi = lane >> 5; const int wid = __builtin_amdgcn_readfirstlane(tid >> 6);
    const int nb = (wid < 4) ? wid : 7 - wid, eb = wid >> 2, db = wid & 3;
    const long rowbase = (long)b * SEQ;
    const float lgam = __builtin_log2f(1.0f - __builtin_exp2f(-5.0f - (float)h)); const float g128 = __builtin_exp2f(128.0f * lgam);
    const int krow = 4 * wid + (lane >> 4), kx = ((lane >> 4) << 2) | (wid & 3);
    const bf16_t* ksrc = RK + (rowbase + krow) * D + h * 128 + (((lane & 15) ^ kx) * 8);
    const bf16_t* qdsrc = RQ + (rowbase + krow) * D + h * 128 + (((lane & 15) ^ kx) * 8);
    const bf16_t* vsrc = RV + (rowbase + 16 * wid + (lane >> 2)) * 2048 + h * 256 + sl * 64 + (lane & 3) * 8;
#define RT_DMA(c, buf) do { \
        _Pragma("unroll") for (int k_ = 0; k_ < 4; ++k_) __builtin_amdgcn_global_load_lds((const unsigned*)(ksrc + ((long)(c) * 128 + 32 * k_) * D), (LAS unsigned*)(lds + (buf) * KV_BYTES + (wid + 8 * k_) * 1024), 16, 0, 0); \
        _Pragma("unroll") for (int k_ = 0; k_ < 2; ++k_) __builtin_amdgcn_global_load_lds((const unsigned*)(vsrc + (long)(c) * 128 * 2048 + k_ * 32), (LAS unsigned*)(lds + (buf) * KV_BYTES + V_OFF + k_ * 8192 + wid * 1024), 16, 0, 0); } while (0)
#define RT_DMAQ(c) do { \
        _Pragma("unroll") for (int k_ = 0; k_ < 4; ++k_) __builtin_amdgcn_global_load_lds((const unsigned*)(qdsrc + ((long)(c) * 128 + 32 * k_) * D), (LAS unsigned*)(lds + Q_OFF + (wid + 8 * k_) * 1024), 16, 0, 0); } while (0)
    RT_DMA(0, 0); RT_DMAQ(0);
    { LAS u32x4* z = (LAS u32x4*)(lds + ST_OFF + wid * 2048); z[lane] = (u32x4){0u, 0u, 0u, 0u}; z[64 + lane] = (u32x4){0u, 0u, 0u, 0u}; }
    f32x16 st = {};
    const unsigned xr = ((r32 & 3) << 2) | ((r32 >> 2) & 3);
    const unsigned ka0 = 256u * r32 + 16u * ((unsigned)hi ^ xr);
    const unsigned q4 = (lane & 15) >> 2, p4 = lane & 3, blk = (lane >> 4) & 1;
    unsigned kt[2];
#pragma unroll
    for (int t = 0; t < 2; ++t) kt[t] = offb(8 * t + 4 * hi + q4, 4 * db + 2 * blk + (p4 >> 1)) + 8 * (p4 & 1);
    const unsigned vt = V_OFF + eb * 8192 + blk * 32 + p4 * 8 + (4 * hi + q4) * 64;
    const unsigned sa = (32 * eb + r32) * 256;
    const unsigned sx = (unsigned)(r32 & 15);
    const unsigned ldsb = (unsigned)(size_t)lds;
    bf16_t* osrc = RV + (rowbase + 32 * nb) * 2048 + h * 256 + sl * 64 + 32 * eb + r32;
    const LAS unsigned char* sp = lds + ST_OFF + sa;
    const LAS unsigned char* qbase = lds + Q_OFF + nb * 8192;
    constexpr int NC = SEQ / 128;
    for (int c = 0; c < NC; ++c) {
        const int buf = c & 1;
        { const unsigned long long t0_ = pcls ? __builtin_amdgcn_s_memrealtime() : 0ull;
          asm volatile("s_waitcnt vmcnt(0) lgkmcnt(0)\n\ts_barrier" ::: "memory");
          if (pcls == 16) tacc += __builtin_amdgcn_s_memrealtime() - t0_; }
        const unsigned long long t1_ = (pcls == 17) ? __builtin_amdgcn_s_memrealtime() : 0ull;
        if (c + 1 < NC) RT_DMA(c + 1, buf ^ 1);
        const unsigned kvb = ldsb + buf * KV_BYTES;
        const LAS unsigned char* kbase = lds + buf * KV_BYTES;
        f32x16 o = {};
        bf16x8 qf[8], ka[8];
#define RT_LDK(dst, mb_) do { _Pragma("unroll") for (int s_ = 0; s_ < 8; ++s_) dst[s_] = *(const LAS bf16x8*)(kbase + (mb_) * 8192 + (ka0 ^ ((unsigned)s_ << 5))); } while (0)
#define RT_LDV(mb_) do { const unsigned va_ = kvb + vt + (unsigned)(mb_) * 2048u; \
        asm volatile("ds_read_b64_tr_b16 %0,%1" : "=&v"(vl0) : "v"(va_) : "memory"); asm volatile("ds_read_b64_tr_b16 %0,%1 offset:512" : "=&v"(vu0) : "v"(va_) : "memory"); \
        asm volatile("ds_read_b64_tr_b16 %0,%1 offset:1024" : "=&v"(vl1) : "v"(va_) : "memory"); asm volatile("ds_read_b64_tr_b16 %0,%1 offset:1536" : "=&v"(vu1) : "v"(va_) : "memory"); } while (0)
        {
            bf16x8 sf[8];
#pragma unroll
            for (int s = 0; s < 8; ++s) qf[s] = *(const LAS bf16x8*)(qbase + (ka0 ^ ((unsigned)s << 5)));
#pragma unroll
            for (int s = 0; s < 8; ++s) sf[s] = *(const LAS bf16x8*)(sp + ((((unsigned)(2 * s + hi)) ^ sx) << 4));
            RT_LDK(ka, 0); SBAR();
#pragma unroll
            for (int s = 0; s < 8; ++s) o = __builtin_amdgcn_mfma_f32_32x32x16_bf16(qf[s], sf[s], o, 0, 0, 0);
            SBAR();
        }
        asm volatile("s_waitcnt lgkmcnt(0)\n\ts_barrier" : "+v"(qf[0]), "+v"(qf[1]), "+v"(qf[2]), "+v"(qf[3]), "+v"(qf[4]), "+v"(qf[5]), "+v"(qf[6]), "+v"(qf[7]) :: "memory");
        if (c + 1 < NC) RT_DMAQ(c + 1);
        {
#define RT_STEP(mb_) do { f32x16 p_ = {}; \
            _Pragma("unroll") for (int s_ = 0; s_ < 8; ++s_) p_ = __builtin_amdgcn_mfma_f32_32x32x16_bf16(ka[s_], qf[s_], p_, 0, 0, 0); \
            SBAR(); if ((mb_) < nb) { RT_LDK(ka, (mb_) + 1); } SBAR(); \
            s16x4 vl0, vu0, vl1, vu1; RT_LDV(mb_); \
            if ((mb_) == nb) { _Pragma("unroll") for (int r_ = 0; r_ < 16; ++r_) if (sb::crow(r_, hi) > r32) p_[r_] = 0.f; } \
            const u32x4 pa_ = {cvtpk(p_[0], p_[1]), cvtpk(p_[2], p_[3]), cvtpk(p_[4], p_[5]), cvtpk(p_[6], p_[7])}, pb_ = {cvtpk(p_[8], p_[9]), cvtpk(p_[10], p_[11]), cvtpk(p_[12], p_[13]), cvtpk(p_[14], p_[15])}; \
            asm volatile("s_waitcnt lgkmcnt(0)" : "+v"(vl0), "+v"(vu0), "+v"(vl1), "+v"(vu1) :: "memory"); \
            o = __builtin_amdgcn_mfma_f32_32x32x16_bf16(__builtin_bit_cast(bf16x8, pa_), ((bf16x8){vl0[0], vl0[1], vl0[2], vl0[3], vu0[0], vu0[1], vu0[2], vu0[3]}), o, 0, 0, 0); \
            o = __builtin_amdgcn_mfma_f32_32x32x16_bf16(__builtin_bit_cast(bf16x8, pb_), ((bf16x8){vl1[0], vl1[1], vl1[2], vl1[3], vu1[0], vu1[1], vu1[2], vu1[3]}), o, 0, 0, 0); SBAR(); } while (0)
            RT_STEP(0);
            if (nb >= 1) { RT_STEP(1); if (nb >= 2) { RT_STEP(2); if (nb >= 3) { RT_STEP(3); } } }
#undef RT_STEP
        }
#undef RT_LDV
#undef RT_LDK
        if (pcls == 17) tacc += __builtin_amdgcn_s_memrealtime() - t1_;
#pragma unroll
        for (int half = 0; half < 2; ++half) {
            s16x4 lo[4], up[4], vl[4], vu[4];
#pragma unroll
            for (int q = 0; q < 4; ++q) { const int ks = half * 4 + q;
                asm volatile("ds_read_b64_tr_b16 %0,%1 offset:%c2" : "=&v"(lo[q]) : "v"(kvb + kt[0]), "i"(ks * 4096) : "memory");
                asm volatile("ds_read_b64_tr_b16 %0,%1 offset:%c2" : "=&v"(up[q]) : "v"(kvb + kt[1]), "i"(ks * 4096) : "memory");
                asm volatile("ds_read_b64_tr_b16 %0,%1 offset:%c2" : "=&v"(vl[q]) : "v"(kvb + vt), "i"(ks * 1024) : "memory");
                asm volatile("ds_read_b64_tr_b16 %0,%1 offset:%c2" : "=&v"(vu[q]) : "v"(kvb + vt), "i"(ks * 1024 + 512) : "memory"); }
            asm volatile("s_waitcnt lgkmcnt(0)" : "+v"(lo[0]), "+v"(lo[1]), "+v"(lo[2]), "+v"(lo[3]), "+v"(up[0]), "+v"(up[1]), "+v"(up[2]), "+v"(up[3]),
                                                   "+v"(vl[0]), "+v"(vl[1]), "+v"(vl[2]), "+v"(vl[3]), "+v"(vu[0]), "+v"(vu[1]), "+v"(vu[2]), "+v"(vu[3]) :: "memory");
#pragma unroll
            for (int q = 0; q < 4; ++q) { const bf16x8 kf = (bf16x8){lo[q][0], lo[q][1], lo[q][2], lo[q][3], up[q][0], up[q][1], up[q][2], up[q][3]}, vf = (bf16x8){vl[q][0], vl[q][1], vl[q][2], vl[q][3], vu[q][0], vu[q][1], vu[q][2], vu[q][3]};
                st = __builtin_amdgcn_mfma_f32_32x32x16_bf16(kf, vf, st, 0, 0, 0); }
        }
#pragma unroll
        for (int r = 0; r < 16; ++r) st[r] *= g128;
        { LAS unsigned char* spw = lds + ST_OFF + sa;
#pragma unroll
            for (int g = 0; g < 4; ++g) { u32x2 w; w.x = cvtpk(st[4 * g], st[4 * g + 1]); w.y = cvtpk(st[4 * g + 2], st[4 * g + 3]);
                *(LAS u32x2*)(spw + ((((unsigned)(4 * db + g)) ^ sx) << 4) + 8 * hi) = w; } }
        { bf16_t* op = osrc + (long)c * 128 * 2048;
#pragma unroll
            for (int r = 0; r < 16; ++r) op[(long)sb::crow(r, hi) * 2048] = (bf16_t)(cvtpk(o[r], 0.f) & 0xffffu); }
    }
    asm volatile("s_waitcnt vmcnt(0) lgkmcnt(0)\n\ts_barrier" ::: "memory");
#undef RT_DMAQ
#undef RT_DMA
}
}

__device__ __forceinline__ int moe_prepare(Frame& F, int layer, int ncol, bool gather) {
    LAS int* info = (LAS int*)(F.lds + TBL_OFF); LAS int* tok = info + 64;
    const unsigned* gcnt = F.ctl + CW_GCNT + layer * 64; const int* LIST = (const int*)(F.ws + WS_LIST);
    int cnt[NBUCKET]; int RT = 0;
#pragma unroll
    for (int q = 0; q < NBUCKET; ++q) { cnt[q] = (int)__hip_atomic_load(gcnt + q, __ATOMIC_RELAXED, __HIP_MEMORY_SCOPE_AGENT); RT += (cnt[q] + 255) >> 8; }
    for (int i = 0; i < MAXU; ++i) {
        const int L = i * F.G + F.vcu;
        if (L >= RT * ncol) { if (F.tid == 0) info[i * 8] = 0; continue; }
        const int rt = L / ncol, ct = L % ncol; int bucket = 0, ti = 0, cb = 0, accT = 0;
#pragma unroll
        for (int q = 0; q < NBUCKET; ++q) { const int nbk = (cnt[q] + 255) >> 8; if (rt >= accT && rt < accT + nbk) { bucket = q; ti = rt - accT; cb = cnt[q]; } accT += nbk; }
        const int nvalid = (cb - ti * 256) < 256 ? (cb - ti * 256) : 256;
        if (F.tid == 0) { info[i * 8 + 0] = 1; info[i * 8 + 1] = rt; info[i * 8 + 2] = ct; info[i * 8 + 3] = bucket; info[i * 8 + 4] = ti; info[i * 8 + 5] = nvalid; }
        if (gather && F.tid < 256) tok[i * 256 + F.tid] = (F.tid < nvalid) ? (LIST[(size_t)bucket * T + ti * 256 + F.tid] << 10) : 0;
    }
    __syncthreads();
    return RT;
}
constexpr size_t PJ_XG8 = 256 * MiB;
__device__ __forceinline__ void gather_phase(Frame& F, int layer) {
    LAS int* tinfo = (LAS int*)(F.lds + TBL_OFF);
    const unsigned* gcnt = F.ctl + CW_GCNT + layer * 64; const int* LIST = (const int*)(F.ws + WS_LIST);
    int cnt[NBUCKET]; int RT = 0;
#pragma unroll
    for (int q = 0; q < NBUCKET; ++q) { cnt[q] = (int)__hip_atomic_load(gcnt + q, __ATOMIC_RELAXED, __HIP_MEMORY_SCOPE_AGENT); RT += (cnt[q] + 255) >> 8; }
    if (F.tid < 160) { const int rt = F.tid; int bucket = 0, ti = 0, cb = 0, accT = 0;
#pragma unroll
        for (int q = 0; q < NBUCKET; ++q) { const int nbk = (cnt[q] + 255) >> 8; if (rt >= accT && rt < accT + nbk) { bucket = q; ti = rt - accT; cb = cnt[q]; } accT += nbk; }
        const int nvalid = (cb - ti * 256) < 256 ? (cb - ti * 256) : 256;
        tinfo[2 * rt] = bucket * T + ti * 256; tinfo[2 * rt + 1] = (rt < RT) ? nvalid : 0; }
    __syncthreads();
    const unsigned char* XN8 = F.ws + WS_XN8; unsigned char* XG8 = F.ws + WS_PROJ + PJ_XG8;
    const int gw = F.vcu * 8 + F.wave, NGW = F.G * 8;
    for (int g0 = gw; g0 < RT * 256; g0 += 8 * NGW) {
        int tok[8];
#pragma unroll
        for (int k = 0; k < 8; ++k) { const int g = g0 + k * NGW; tok[k] = -1;
            if (g < RT * 256) { const int rt = g >> 8, r = g & 255; if (r < tinfo[2 * rt + 1]) tok[k] = LIST[tinfo[2 * rt] + r]; } }
        u32x4 v[8];
#pragma unroll
        for (int k = 0; k < 8; ++k) { v[k] = (u32x4){0u, 0u, 0u, 0u}; if (tok[k] >= 0) v[k] = __builtin_nontemporal_load((const u32x4*)(XN8 + (size_t)tok[k] * D + F.lane * 16)); }
#pragma unroll
        for (int k = 0; k < 8; ++k) { const int g = g0 + k * NGW; if (g < RT * 256) *(u32x4*)(XG8 + (size_t)g * D + F.lane * 16) = v[k]; }
    }
}
template <bool UP> struct MoeSched {
    static constexpr bool GATHER = UP, FP8 = true;
    LAS const int* info; LAS const int* tok; const bf16_t* A; const bf16_t* W; int tid;
    __device__ __forceinline__ bool next(int i, gp::UnitG& u, gp::LaneVA& va) const {
        if (i >= MAXU) return false;
        if (__builtin_amdgcn_readfirstlane(info[i * 8]) == 0) return false;
        const int rt = __builtin_amdgcn_readfirstlane(info[i * 8 + 1]), ct = __builtin_amdgcn_readfirstlane(info[i * 8 + 2]), bucket = __builtin_amdgcn_readfirstlane(info[i * 8 + 3]),
                  ti = __builtin_amdgcn_readfirstlane(info[i * 8 + 4]), nvalid = __builtin_amdgcn_readfirstlane(info[i * 8 + 5]);
        const int g = bucket / 6, pr = bucket % 6; const int la = pr < 3 ? 0 : (pr < 5 ? 1 : 2), lb = pr < 3 ? pr + 1 : (pr < 5 ? pr - 1 : 3);
        u.pm = rt; u.pn = ct; u.x0 = bucket * T + ti * 256; u.x1 = nvalid;
        if constexpr (UP) {
            const int e = 4 * g + ((ct < 4) ? la : lb);
            u.a0 = (const char*)A; u.tb = TBL_OFF + 256 + i * 1024; u.b0 = (const char*)W + ((size_t)e * 1024 + (size_t)(ct & 3) * 256) * 1024; u.bjump = 0u; u.bsplit = 1 << 30;
        } else {
            u.a0 = (const char*)A + (size_t)rt * 256 * D; u.tb = 0; u.b0 = (const char*)W + (((size_t)g * 1024 + (size_t)ct * 256) * 2048 + (size_t)la * 512); u.bjump = (unsigned)(lb - la - 1) * 512u; u.bsplit = 4;
        }
        return true;
    }
};

__device__ __forceinline__ void launder(Frame& F) { int w_ = F.wave0; asm volatile("" : "+s"(w_)); unsigned m_ = ~0u; asm volatile("" : "+s"(m_)); int l_ = __builtin_amdgcn_mbcnt_hi(m_, __builtin_amdgcn_mbcnt_lo(m_, 0u)); asm volatile("" : "+v"(l_));     F.lane = l_; F.wave = w_; F.tid = w_ * 64 + l_;
    F.out = (float*)kin(17); F.ws = (unsigned char*)kin(18); F.ctl = (unsigned*)(F.ws + WS_CTL);
    int g_ = gridDim.x, bx_ = blockIdx.x; asm volatile("" : "+s"(g_), "+s"(bx_)); F.G = g_; F.bx = bx_; F.vcu = (g_ % 8 == 0) ? (bx_ % 8) * (g_ / 8) + bx_ / 8 : bx_; }
#ifndef MK_PER_PHASE
#define MK_PER_PHASE 0
#endif
constexpr int N_PHASES = 2 + 9 * DEPTH;
struct Args { const void* in[17]; float* out; unsigned char* ws; int ph_lo, ph_hi; };
__global__ void __launch_bounds__(512, 2) fwd(Args args) {
    extern __shared__ __attribute__((aligned(16))) unsigned char lds_raw[];
    Frame F;
    F.lds = (LAS unsigned char*)lds_raw; F.ws = args.ws; F.ctl = (unsigned*)(args.ws + WS_CTL);
    F.tid = threadIdx.x; F.lane = F.tid & 63; F.wave = __builtin_amdgcn_readfirstlane(F.tid >> 6); F.wave0 = F.wave;
    F.G = gridDim.x; { const int bx = blockIdx.x; F.bx = bx; F.vcu = (F.G % 8 == 0) ? (bx % 8) * (F.G / 8) + bx / 8 : bx; }
    F.out = args.out;
    for (int u = F.tid; u < (LDS_BYTES - LDSCTL_OFF) / 4; u += 512) ((LAS unsigned*)(F.lds + LDSCTL_OFF))[u] = 0u;
    __syncthreads();
    XcdBarrier bar; bar.bar = F.ctl + CW_BAR; bar.x = 0; bar.st = nullptr;
    if (!MK_PER_PHASE) bar = xcd_barrier_post(F.ctl + CW_BAR, (volatile LAS unsigned*)(F.lds + LDSCTL_OFF + 32));
    const int lo = args.ph_lo, hi = args.ph_hi;
#ifndef PH_MASK
#define PH_MASK 0xFFFF
#endif
#define IN(k) (lo <= (k) && (k) < hi)
#ifndef PROBE_CLASS
#define PROBE_CLASS 0
#endif
#ifndef PROBE_MULT
#define PROBE_MULT 2
#endif
    unsigned long long tsel = 0ull, tph0 = 0ull;
#define PT0() do { if (PROBE_CLASS) tph0 = __builtin_amdgcn_s_memrealtime(); } while (0)
#define PT1(cls) do { if (PROBE_CLASS && (cls) == PROBE_CLASS) tsel += __builtin_amdgcn_s_memrealtime() - tph0; } while (0)
#define PM(bit) (launder(F), (PH_MASK >> (bit)) & 1)
#define GRID_BAR() do { if (!MK_PER_PHASE) { XcdBarrier b2_ = bar; asm volatile("" : "+s"(b2_.bar)); xcd_barrier(b2_); } } while (0)
#define PJ (F.ws + WS_PROJ)
#define XN ((bf16_t*)(F.ws + WS_XN))

    if (PM(0) && IN(0)) { PT0(); p0_prologue(F); GRID_BAR(); PT1(7); }
    if (PM(1) && IN(1)) { PT0(); p1_mod0(F); GRID_BAR(); PT1(7); }
    for (int L = 0; L < DEPTH; ++L) {
        const int pb = 2 + 9 * L, ml = L >> 1;
        const bf16_t* Ymix;
        if ((L & 1) == 0) {
            bf16_t* Q = (bf16_t*)(PJ + PJ_Q); Ymix = (const bf16_t*)(PJ + PJ_K);
            if (PM(2) && IN(pb + 0)) {
                PT0();
                gp::PlainSched S; S.A = XN; S.Bt = (const bf16_t*)(F.ws + WS_WQKV) + (size_t)ml * 3072 * 1024; S.lda = D; S.ldb = D; S.tid = F.tid; S.so.init(T, 3072, F.G, F.bx);
                gp::EpiQKV E{Q, SB_QSCALE};
                gp::gemm_phase<gp::EpiQKV, gp::PlainSched>(F.lds, F.tid, D, D, D, S, E, tsel, 1);
                GRID_BAR(); PT1(1); PT1(8);
            }
            if (PM(3) && IN(pb + 1)) {
                PT0();
                const int NU = BATCH * 16 * (SEQ / 256);
                for (int uu = F.vcu; uu < NU; uu += F.G) { const int bh = uu >> 4, qb = uu & 15; const int un = uu + F.G; const bool hn = un < NU;
                    sb::unit(F.tid, bh >> 4, bh & 15, qb, Q, Q + (size_t)T * D, Q + (size_t)2 * T * D, PJ + 192 * MiB, F.lds, uu != F.vcu, hn ? (un >> 8) : 0, hn ? ((un >> 4) & 15) : 0, hn ? (un & 15) : -1, tsel, PROBE_CLASS); }
                asm volatile("s_barrier" ::: "memory");
                { const unsigned long long tw_ = PROBE_CLASS ? __builtin_amdgcn_s_memrealtime() : 0ull; if (PROBE_CLASS == 15) tsel += tw_ - tph0; moe_weight_phase(F, L, (L == 0) ? 0 : 8192, 12288, F.vcu, F.G); if (PROBE_CLASS == 13) tsel += __builtin_amdgcn_s_memrealtime() - tw_; }
                GRID_BAR(); PT1(2);
            }
        } else {
            bf16_t* RQ = (bf16_t*)(PJ + PJ_RQ); bf16_t* RK = (bf16_t*)(PJ + PJ_RK); bf16_t* RV = (bf16_t*)(PJ + PJ_RV); bf16_t* RG = (bf16_t*)(PJ + PJ_RG); Ymix = (const bf16_t*)(PJ + PJ_RQ);
            if (PM(4) && IN(pb + 0)) {
                PT0();
                gp::PlainSched S; S.A = XN; S.Bt = (const bf16_t*)(F.ws + WS_WRI) + (size_t)ml * 6144 * 1024; S.lda = D; S.ldb = D; S.tid = F.tid; S.so.init(T, 6144, F.G, F.bx);
                gp::EpiRet E{RQ, RK, RV, RG, (const f32x2*)(F.ws + WS_CS)};
                gp::gemm_phase<gp::EpiRet, gp::PlainSched>(F.lds, F.tid, D, D, D, S, E, tsel, 2);
                GRID_BAR(); PT1(1); PT1(11);
            }
            if (PM(5) && IN(pb + 1)) {
                PT0();
                for (int uu = F.vcu; uu < BATCH * 8 * 4; uu += F.G) { const int bh = uu >> 2; ret::unit(F.tid, bh >> 3, bh & 7, uu & 3, RQ, RK, RV, F.lds, tsel, PROBE_CLASS); }
                { const unsigned long long tw_ = PROBE_CLASS ? __builtin_amdgcn_s_memrealtime() : 0ull; if (PROBE_CLASS == 14) tsel += tw_ - tph0; moe_weight_phase(F, L, (L == 0) ? 0 : 8192, 12288, F.vcu, F.G); if (PROBE_CLASS == 13) tsel += __builtin_amdgcn_s_memrealtime() - tw_; }
                GRID_BAR(); PT1(3);
            }
            if (PM(6) && IN(pb + 2)) { PT0(); gate_phase(F, ml); GRID_BAR(); PT1(6); }
        }
        if (PM(7) && IN(pb + 3)) {
            PT0();
            if ((L & 1) == 0) {
                gp::PlainSchedT<true> S; S.A = (const bf16_t*)(PJ + 192 * MiB); S.Bt = (const bf16_t*)(F.ws + WS_WSO + (size_t)ml * 2 * MiB);
                int K8 = D / 2; asm volatile("" : "+s"(K8));
                S.lda = K8; S.ldb = K8; S.tid = F.tid; S.so.init(T, D, F.G, F.bx);
                gp::EpiY E{(bf16_t*)Ymix, 1.0f / (64.0f * 64.0f)};
                gp::gemm_phase<gp::EpiY, gp::PlainSchedT<true>>(F.lds, F.tid, K8, K8, K8, S, E, tsel, 3);
            } else {
                gp::PlainSchedT<true> S; S.A = (const bf16_t*)(PJ + PJ_RK); S.Bt = (const bf16_t*)(F.ws + WS_WRO + (size_t)ml * 2 * MiB);
                int K8 = D; asm volatile("" : "+s"(K8));
                S.lda = K8; S.ldb = K8; S.tid = F.tid; S.so.init(T, D, F.G, F.bx);
                gp::EpiY E{(bf16_t*)Ymix, 1.0f / (16.0f * 64.0f)};
                gp::gemm_phase<gp::EpiY, gp::PlainSchedT<true>>(F.lds, F.tid, K8, K8, K8, S, E, tsel, 4);
            }
            GRID_BAR(); PT1(1); PT1(12);
        }
        if (PM(8) && IN(pb + 4)) { PT0(); ln_phase(F, Ymix, 2 * L, 2 * L + 1, true, L); GRID_BAR(); PT1(4); }
        if (0 && PM(9) && IN(pb + 5)) { PT0(); gather_phase(F, L); GRID_BAR(); PT1(18); }
        if (PM(9) && IN(pb + 6)) {
            PT0();
            const int RTu = moe_prepare(F, L, 8, true);
            MoeSched<true> S{(LAS const int*)(F.lds + TBL_OFF), (LAS const int*)(F.lds + TBL_OFF) + 64, (const bf16_t*)(F.ws + WS_XN8), (const bf16_t*)(F.ws + WS_WGU), F.tid};
            gp::EpiUp E{(bf16_t*)(PJ + PJ_HID), (const f32x2*)(F.ws + WS_WTS), 16.0f, 1.0f / 64.0f};
            int K8 = D / 2; asm volatile("" : "+s"(K8));
            gp::gemm_phase<gp::EpiUp, MoeSched<true>>(F.lds, F.tid, K8, K8, K8, S, E, tsel, 5);
            if (L == 0) { const int rem = (RTu * 8) % F.G;
                if (rem == 0) late_prologue(F, F.vcu, F.G); else if (F.vcu >= rem) late_prologue(F, F.vcu - rem, F.G - rem); }
            GRID_BAR(); PT1(1); PT1(9);
        }
        if (PM(10) && IN(pb + 7)) {
            PT0();
            const int RTd = moe_prepare(F, L, 4, false);
            MoeSched<false> S{(LAS const int*)(F.lds + TBL_OFF), (LAS const int*)(F.lds + TBL_OFF) + 64, (const bf16_t*)(PJ + PJ_HID), (const bf16_t*)(F.ws + WS_WD), F.tid};
            gp::EpiDown E{(bf16_t*)(PJ + PJ_Y2), (const int*)(F.ws + WS_LIST), 1.0f / (16.0f * 64.0f)};
            int K8 = D / 2; asm volatile("" : "+s"(K8));
            gp::gemm_phase<gp::EpiDown, MoeSched<false>>(F.lds, F.tid, K8, K8, 2 * K8, S, E, tsel, 6);
            if (L + 1 < DEPTH) {
                const int rem = (RTd * 4) % F.G;
                if (rem == 0) moe_weight_phase(F, L + 1, 0, 8192, F.vcu, F.G);
                else if (F.vcu >= rem) moe_weight_phase(F, L + 1, 0, 8192, F.vcu - rem, F.G - rem);
            }
            GRID_BAR(); PT1(1); PT1(10);
        }
        if (PM(11) && IN(pb + 8)) { PT0(); ln_phase(F, (const bf16_t*)(PJ + PJ_Y2), 2 * L + 1, (L + 1 < DEPTH) ? 2 * L + 2 : -1, false, L); if (L + 1 < DEPTH) GRID_BAR(); PT1(5); }
    }
    if (PROBE_CLASS) { const unsigned long long te = __builtin_amdgcn_s_memrealtime(); while (__builtin_amdgcn_s_memrealtime() - te < (PROBE_CLASS == 44 ? tsel / 20ull : (unsigned long long)PROBE_MULT * tsel)) __builtin_amdgcn_s_sleep(8); }
#undef IN
#undef GRID_BAR
}

__global__ void dbg_dump(const bf16_t* src, float* out) { for (size_t i = blockIdx.x * 256 + threadIdx.x; i < (size_t)T * D; i += 1024 * 256) out[i] = bf2f(src[i]); }
extern "C" void kernel_launch(void* const* d_in, const int* in_sizes, int n_in, void* d_out, int out_size, void* d_ws, size_t ws_size, hipStream_t stream) {
    static int grid = 0;
    if (grid == 0) {
        if (n_in != 17 || in_sizes[0] != T * D || out_size != T * D || ws_size < WS_END) { fprintf(stderr, "kernel_launch: unexpected shapes / workspace (%d inputs, ws %zu)\n", n_in, ws_size); grid = -1; return; }
        int dev = 0, cus = 0, per_cu = 0;
        if (hipGetDevice(&dev) != hipSuccess || hipDeviceGetAttribute(&cus, hipDeviceAttributeMultiprocessorCount, dev) != hipSuccess) { grid = -1; return; }
        if (hipFuncSetAttribute((const void*)fwd, hipFuncAttributeMaxDynamicSharedMemorySize, LDS_BYTES) != hipSuccess) { fprintf(stderr, "kernel_launch: hipFuncSetAttribute failed\n"); grid = -1; return; }
        if (hipOccupancyMaxActiveBlocksPerMultiprocessor(&per_cu, (const void*)fwd, 512, LDS_BYTES) != hipSuccess || per_cu < 1) { fprintf(stderr, "kernel_launch: occupancy query reports %d\n", per_cu); }
        (void)hipGetLastError();
        grid = cus;
        if (grid > 256) grid = 256;
        while (grid > 8 && ((T % grid) != 0 || (SEQ % (T / grid)) != 0 || (grid % 8) != 0)) --grid;
    }
    if (grid < 0) return;
    (void)hipMemsetAsync((char*)d_ws, 0, ZERO_BYTES, stream);
    Args a{};
    for (int i = 0; i < 17; ++i) a.in[i] = d_in[i];
    a.out = (float*)d_out; a.ws = (unsigned char*)d_ws;
#if MK_PER_PHASE
#ifndef DBG_STOP
#define DBG_STOP N_PHASES
#endif
#ifndef DBG_OFF
#define DBG_OFF (-1)
#endif
    for (int p = 0; p < DBG_STOP; ++p) { a.ph_lo = p; a.ph_hi = p + 1; hipLaunchKernelGGL(fwd, dim3(grid), dim3(512), LDS_BYTES, stream, a); }
    if (DBG_OFF >= 0) hipLaunchKernelGGL(dbg_dump, dim3(1024), dim3(256), 0, stream, (const bf16_t*)((const unsigned char*)d_ws + (size_t)DBG_OFF * MiB), (float*)d_out);
#else
    a.ph_lo = 0; a.ph_hi = N_PHASES;
    hipLaunchKernelGGL(fwd, dim3(grid), dim3(512), LDS_BYTES, stream, a);
#endif
}
```
